# Optimizing an MI355X kernel written in HIP

```python
import jax, jax.numpy as jnp
from jax import lax
import numpy as np

D_MODEL = 1024
BATCH = 8
SEQ = 2048
DEPTH = 2
DEC_BATCH = 128
DEC_SEQ = 1
PAST_LEN = 16384
PAGE_SIZE = 128

E_A = D_MODEL
G_A = 4
HD_A = E_A // G_A
CHUNK = 128
E_B = D_MODEL
CONV_W = 3
D_FF = 2816
EPS = 1e-6
IN_COLS = 2 * E_A + 3 * E_B + 2 * D_MODEL
SPLITS = (E_A, 2 * E_A, 2 * E_A + E_B, 2 * E_A + 2 * E_B, 2 * E_A + 3 * E_B, 2 * E_A + 3 * E_B + D_MODEL)

kernel_name = "hybrid_chunkmlp_shortconv_macaron_step"


def rms_norm(x, g):
    xf = x.astype(jnp.float32)
    y = xf * lax.rsqrt(jnp.mean(xf * xf, axis=-1, keepdims=True) + EPS)
    return (y * g.astype(jnp.float32)).astype(x.dtype)


def layer_norm(x, g, b):
    xf = x.astype(jnp.float32)
    mu = jnp.mean(xf, axis=-1, keepdims=True)
    xc = xf - mu
    y = xc * lax.rsqrt(jnp.mean(xc * xc, axis=-1, keepdims=True) + EPS)
    return (y * g.astype(jnp.float32) + b.astype(jnp.float32)).astype(x.dtype)


def swiglu(x, w_gate, w_up, w_down):
    return (jax.nn.silu(x @ w_gate) * (x @ w_up)) @ w_down


def chunk_spatial_gate(u, v, w_s, b_s):
    bsz, L, _ = v.shape
    Lp = -(-L // CHUNK) * CHUNK
    vp = jnp.pad(v, ((0, 0), (0, Lp - L), (0, 0)))
    vc = vp.reshape(bsz, Lp // CHUNK, CHUNK, G_A, HD_A)
    causal = jnp.tril(jnp.ones((CHUNK, CHUNK), dtype=bool))
    w = jnp.where(causal[None], w_s, jnp.zeros((), w_s.dtype))
    z = jnp.einsum('gts,bcsgd->bctgd', w, vc) + jnp.transpose(b_s)[None, None, :, :, None]
    z = z.reshape(bsz, Lp, E_A)[:, :L]
    return u * z


def hybrid_layer(x, conv_buf, ffn1_norm, ffn1_w_gate, ffn1_w_up, ffn1_w_down, mix_norm, w_in, b_in,
                 v_ln_gain, v_ln_bias, w_spatial, b_spatial, conv_w, w_out,
                 ffn2_norm, ffn2_w_gate, ffn2_w_up, ffn2_w_down):
    h = x + 0.5 * swiglu(rms_norm(x, ffn1_norm), ffn1_w_gate, ffn1_w_up, ffn1_w_down)
    n = rms_norm(h, mix_norm)
    z = n @ w_in + b_in
    u, v, gate_b, gate_c, x_in, g_a, g_b = jnp.split(z, SPLITS, axis=-1)
    u = jax.nn.gelu(u, approximate=False)
    v = layer_norm(jax.nn.gelu(v, approximate=False), v_ln_gain, v_ln_bias)
    y_a = chunk_spatial_gate(u, v, w_spatial, b_spatial)
    L = x.shape[1]
    xg = gate_c * x_in
    xc = jnp.concatenate([conv_buf.astype(xg.dtype), xg], axis=1)
    conv = conv_w[0] * xc[:, 0:L]
    for k in range(1, CONV_W):
        conv = conv + conv_w[k] * xc[:, k:k + L]
    y_b = gate_b * conv
    new_buf = xc[:, -(CONV_W - 1):]
    m = jax.nn.sigmoid(g_a) * y_a + jax.nn.sigmoid(g_b) * y_b
    h = h + m @ w_out
    h = h + 0.5 * swiglu(rms_norm(h, ffn2_norm), ffn2_w_gate, ffn2_w_up, ffn2_w_down)
    return h, new_buf, v


def setup_inputs(seed: int = 0) -> dict:
    key = jax.random.key(seed)
    ks = jax.random.split(key, 24)
    f32 = jnp.float32
    nrm = lambda k, shape, s: jax.random.normal(k, shape, f32) * s
    d = D_MODEL
    return {
        "x_prompt": nrm(ks[0], (BATCH, SEQ, d), 1.0),
        "x_sample": nrm(ks[1], (DEC_BATCH, DEC_SEQ, d), 1.0),
        "state_conv": nrm(ks[2], (DEPTH, DEC_BATCH, CONV_W - 1, E_B), 0.5),
        "ffn1_norm": 1.0 + nrm(ks[3], (DEPTH, d), 0.02),
        "ffn1_w_gate": nrm(ks[4], (DEPTH, d, D_FF), d ** -0.5),
        "ffn1_w_up": nrm(ks[5], (DEPTH, d, D_FF), d ** -0.5),
        "ffn1_w_down": nrm(ks[6], (DEPTH, D_FF, d), D_FF ** -0.5),
        "mix_norm": 1.0 + nrm(ks[7], (DEPTH, d), 0.02),
        "w_in": nrm(ks[8], (DEPTH, d, IN_COLS), d ** -0.5),
        "b_in": nrm(ks[9], (DEPTH, IN_COLS), 0.02),
        "v_ln_gain": 1.0 + nrm(ks[10], (DEPTH, E_A), 0.02),
        "v_ln_bias": nrm(ks[11], (DEPTH, E_A), 0.02),
        "w_spatial": nrm(ks[12], (DEPTH, G_A, CHUNK, CHUNK), CHUNK ** -0.5),
        "b_spatial": 1.0 + nrm(ks[13], (DEPTH, G_A, CHUNK), 0.02),
        "conv_w": nrm(ks[14], (DEPTH, CONV_W, E_B), CONV_W ** -0.5),
        "w_out": nrm(ks[15], (DEPTH, d, d), d ** -0.5),
        "ffn2_norm": 1.0 + nrm(ks[16], (DEPTH, d), 0.02),
        "ffn2_w_gate": nrm(ks[17], (DEPTH, d, D_FF), d ** -0.5),
        "ffn2_w_up": nrm(ks[18], (DEPTH, d, D_FF), d ** -0.5),
        "ffn2_w_down": nrm(ks[19], (DEPTH, D_FF, d), D_FF ** -0.5),
        "final_norm": 1.0 + nrm(ks[20], (d,), 0.02),
    }


def reference(x_prompt, x_sample, state_conv, ffn1_norm, ffn1_w_gate, ffn1_w_up, ffn1_w_down,
              mix_norm, w_in, b_in, v_ln_gain, v_ln_bias, w_spatial, b_spatial, conv_w, w_out,
              ffn2_norm, ffn2_w_gate, ffn2_w_up, ffn2_w_down, final_norm):
    hp = x_prompt
    hs = x_sample
    conv_p_list, conv_s_list, v_s_list = [], [], []
    for l in range(DEPTH):
        params = (ffn1_norm[l], ffn1_w_gate[l], ffn1_w_up[l], ffn1_w_down[l], mix_norm[l], w_in[l], b_in[l],
                  v_ln_gain[l], v_ln_bias[l], w_spatial[l], b_spatial[l], conv_w[l], w_out[l],
                  ffn2_norm[l], ffn2_w_gate[l], ffn2_w_up[l], ffn2_w_down[l])
        zero_buf = jnp.zeros((hp.shape[0], CONV_W - 1, E_B), dtype=hp.dtype)
        hp, buf_p, _ = hybrid_layer(hp, zero_buf, *params)
        hs, buf_s, v_s = hybrid_layer(hs, state_conv[l], *params)
        conv_p_list.append(buf_p)
        conv_s_list.append(buf_s)
        v_s_list.append(v_s)
    y_prompt = rms_norm(hp, final_norm)
    y_sample = rms_norm(hs, final_norm)
    new_conv_prompt = jnp.stack(conv_p_list, axis=0)
    new_conv_sample = jnp.stack(conv_s_list, axis=0)
    new_chunk_v_sample = jnp.stack(v_s_list, axis=0)
    return (y_prompt, y_sample, new_conv_prompt, new_conv_sample, new_chunk_v_sample)
```

```cpp
#include <hip/hip_runtime.h>
#include <hip/hip_cooperative_groups.h>
#include <cstdio>
#include <cstdint>
namespace cg = cooperative_groups;

#define LAS __attribute__((address_space(3)))
typedef unsigned short bf16_t;
typedef short bf16x8 __attribute__((ext_vector_type(8)));
typedef float f32x4 __attribute__((ext_vector_type(4)));
typedef float f32x2 __attribute__((ext_vector_type(2)));
typedef unsigned u32x4 __attribute__((ext_vector_type(4)));
typedef unsigned u32x2 __attribute__((ext_vector_type(2)));

constexpr int D = 1024, FF = 2816, NIN = 7168, SEQ = 2048, NB = 8, NS = 128, DEPTH = 2;
constexpr int MPR = NB * SEQ;
constexpr int M = MPR + NS;
constexpr int MPAD = 16640;
constexpr float EPS = 1e-6f;
constexpr size_t O_Y = 0, O_NCP = (size_t)M * D, O_NCS = O_NCP + (size_t)DEPTH * NB * 2 * D, O_VS = O_NCS + (size_t)DEPTH * NS * 2 * D;
constexpr size_t MiB = 1u << 20;
constexpr size_t WS_STAT = 0;
constexpr size_t WS_W = 1 * MiB;
constexpr size_t LAYER_W_ELEMS = 25690112;
constexpr size_t OW1 = 0, OW2 = 5767168, OWIN = 8650752, OWO = 15990784, OW6 = 17039360, OW7 = 22806528;
constexpr size_t WS_HB = 99 * MiB;
constexpr size_t ACT_BYTES = (size_t)MPAD * D * 2;
constexpr size_t WS_R = WS_HB + ACT_BYTES;
constexpr size_t WS_END = WS_R + 4 * ACT_BYTES;
constexpr int LDS_BYTES = 147456;

__device__ __forceinline__ unsigned cvt_pk_bf16(float lo, float hi) { unsigned r; asm("v_cvt_pk_bf16_f32 %0, %1, %2" : "=v"(r) : "v"(lo), "v"(hi)); return r; }
__device__ __forceinline__ float bf_lo(unsigned w) { return __uint_as_float(w << 16); }
__device__ __forceinline__ float bf_hi(unsigned w) { return __uint_as_float(w & 0xffff0000u); }
__device__ __forceinline__ float sigmoidf_(float x) { return __builtin_amdgcn_rcpf(1.0f + __builtin_amdgcn_exp2f(-1.44269504089f * x)); }
__device__ __forceinline__ float siluf_(float x) { return x * sigmoidf_(x); }
__device__ __forceinline__ f32x2 gelu_pk(f32x2 v) {
    const f32x2 av = __builtin_elementwise_abs(v), d = av * 0.2316418882f + 1.0f;
    f32x2 t; t.x = __builtin_amdgcn_rcpf(d.x); t.y = __builtin_amdgcn_rcpf(d.y);
    f32x2 q = t * 0.5307027145f + (-0.7265760135f); q = q * t + 0.7107068705f; q = q * t + (-0.142248368f); q = q * t + 0.127414796f; q = q * t;
    const f32x2 s = (v * v) * (-0.72134752044f);
    f32x2 e; e.x = __builtin_amdgcn_exp2f(s.x); e.y = __builtin_amdgcn_exp2f(s.y);
    const f32x2 m = v * (q * e), r = v - m;
    f32x2 o; o.x = v.x < 0.f ? m.x : r.x; o.y = v.y < 0.f ? m.y : r.y; return o;
}
__device__ __forceinline__ f32x4 gelu4(f32x4 v) { f32x2 a = gelu_pk((f32x2){v[0], v[1]}), b = gelu_pk((f32x2){v[2], v[3]}); return (f32x4){a.x, a.y, b.x, b.y}; }
__device__ __forceinline__ float wave_sum(float v) {
#pragma unroll
    for (int o = 1; o < 64; o <<= 1) v += __shfl_xor(v, o);
    return v;
}

namespace pg8 {
constexpr int BM = 256, BK = 64, HALF = 128, HTB = HALF * BK * 2, STAGE_BYTES = 8 * HTB, NXCD = 8, WGM = 8;
__host__ __device__ __forceinline__ int lds_byte(int r, int c) { const int st = (r >> 4) * 2 + (c >> 5), rr = r & 15, cc = c & 31, ob = rr * 64 + cc * 2; return st * 1024 + (ob ^ (((ob >> 9) & 1) << 5)); }
__host__ __device__ __forceinline__ void stage_rc(int b, int& R, int& C) { const int st = b / 1024, sb = b % 1024, swz = sb ^ (((sb >> 9) & 1) << 5); R = (st >> 1) * 16 + swz / 64; C = (st & 1) * 32 + (swz % 64) / 2; }
__host__ __device__ __forceinline__ int perm32(int rho) { const int n = rho >> 4, i = rho & 15; return 8 * (i >> 2) + 4 * n + (i & 3); }
struct Unit { int pm, pn; };
struct Gemm { const bf16_t* A; const bf16_t* Bt; int M, N, K; };
struct StaticOrder {
    int nM, nN, nwg, G, c;
    __device__ void init(int M_, int N_, int G_, int c_) { nM = M_ / BM; nN = N_ / BM; nwg = nM * nN; G = G_; c = c_; }
    __device__ bool next(int i, Unit& u) const {
        const long L = (long)i * G + c; if (L >= nwg) return false;
        int wgid = (int)L; { const int q = nwg / NXCD, r = nwg % NXCD, xcd = wgid % NXCD, off = wgid / NXCD; wgid = (xcd < r ? xcd * (q + 1) : r * (q + 1) + (xcd - r) * q) + off; }
        const int nig = WGM * nN, gid = wgid / nig, fm = gid * WGM, gsz = (nM - fm) < WGM ? (nM - fm) : WGM;
        u.pm = fm + ((wgid % nig) % gsz); u.pn = (wgid % nig) / gsz; return true;
    }
};

template <class Epi, bool ALIGN_EPI>
__device__ __forceinline__ void gemm_phase(LAS unsigned char* lds, const Gemm g, const StaticOrder& S, const Epi& E) {
    int tid_ = threadIdx.x; asm volatile("" : "+v"(tid_));
    const int tid = tid_, wid = __builtin_amdgcn_readfirstlane(tid >> 6), lane = tid & 63, wr = wid >> 2, wc = wid & 3, fr = lane & 15, fq = lane >> 4;
    const int K = g.K, nt = K / BK;
    unsigned voffA[2], voffB[2];
#pragma unroll
    for (int i = 0; i < 2; ++i) { int R, C; stage_rc(tid * 16 + i * 8192, R, C); const int Rb = Epi::PERM ? ((R & ~31) + perm32(R & 31)) : R;
        voffA[i] = (unsigned)(R * K + C) * 2u; voffB[i] = (unsigned)(Rb * K + C) * 2u; }
    const size_t kstep = (size_t)(BK * 2);
    const size_t hstep = (size_t)HALF * K * 2;
    const size_t tstep = 2 * hstep;
    const unsigned ldsw = (unsigned)wid * 1024u;
    const int aoff = lds_byte(wr * 64 + fr, fq * 8), boff = lds_byte(wc * 32 + fr, fq * 8);
#define PG8_SA(b, h) (((b) * 2 + (h)) * HTB)
#define PG8_SB(b, h) ((4 + (b) * 2 + (h)) * HTB)
#define PG8_STAGE(bufoff, gbase, voff) do { _Pragma("unroll") for (int _i = 0; _i < 2; ++_i) \
        __builtin_amdgcn_global_load_lds((const unsigned*)((const char*)(gbase) + (voff)[_i]), (LAS unsigned*)(lds + (bufoff) + ldsw + _i * 8192), 16, 0, 0); } while (0)
#define PG8_LDA(dst, b, h) do { _Pragma("unroll") for (int m = 0; m < 4; ++m) _Pragma("unroll") for (int k = 0; k < 2; ++k) dst[m][k] = *(const LAS bf16x8*)(lds + PG8_SA(b, h) + aoff + m * 2048 + k * 1024); } while (0)
#define PG8_LDB(dst, b, h) do { _Pragma("unroll") for (int n = 0; n < 2; ++n) _Pragma("unroll") for (int k = 0; k < 2; ++k) dst[n][k] = *(const LAS bf16x8*)(lds + PG8_SB(b, h) + boff + n * 2048 + k * 1024); } while (0)
#define PG8_MMA(ai, bj, At, Bt) do { __builtin_amdgcn_s_setprio(1); _Pragma("unroll") for (int m = 0; m < 4; ++m) _Pragma("unroll") for (int n = 0; n < 2; ++n) _Pragma("unroll") for (int k = 0; k < 2; ++k) \
        acc[ai][bj][m][n] = __builtin_amdgcn_mfma_f32_16x16x32_bf16(Bt[n][k], At[m][k], acc[ai][bj][m][n], 0, 0, 0); __builtin_amdgcn_s_setprio(0); } while (0)
#define PG8_WAIT_V(n) asm volatile("s_waitcnt vmcnt(" #n ")" ::: "memory")
#define PG8_WAIT_L(n) asm volatile("s_waitcnt lgkmcnt(" #n ")" ::: "memory")
#define PG8_BAR __builtin_amdgcn_s_barrier()
#define PG8_SCHED __builtin_amdgcn_sched_barrier(0)
    Unit cur, nxt; int ui = 0;
    if (!S.next(0, cur)) return;
    f32x4 acc[2][2][4][2];
#pragma unroll
    for (int a = 0; a < 2; ++a)
#pragma unroll
        for (int b = 0; b < 2; ++b)
#pragma unroll
            for (int m = 0; m < 4; ++m)
#pragma unroll
                for (int n = 0; n < 2; ++n) acc[a][b][m][n] = (f32x4){0.f, 0.f, 0.f, 0.f};
    bf16x8 At[4][2], B0[2][2], B1[2][2];
    const char* cA = (const char*)g.A + (size_t)cur.pm * tstep; const char* cB = (const char*)g.Bt + (size_t)cur.pn * tstep;
    PG8_STAGE(PG8_SB(0, 0), cB, voffB); PG8_STAGE(PG8_SB(0, 1), cB + hstep, voffB); PG8_STAGE(PG8_SA(0, 0), cA, voffA); PG8_STAGE(PG8_SA(0, 1), cA + hstep, voffA);
    if (wr == 1) PG8_BAR;
    PG8_WAIT_V(2); PG8_BAR;
    PG8_STAGE(PG8_SB(1, 0), cB + kstep, voffB); PG8_STAGE(PG8_SA(1, 0), cA + kstep, voffA); PG8_STAGE(PG8_SB(1, 1), cB + hstep + kstep, voffB);
    PG8_WAIT_V(6); PG8_BAR;
    for (;;) {
        const bool has_next = S.next(ui + 1, nxt);
        const char* nA = has_next ? (const char*)g.A + (size_t)nxt.pm * tstep : cA; const char* nB = has_next ? (const char*)g.Bt + (size_t)nxt.pn * tstep : cB;
        for (int t = 0; t < nt; t += 2) {
            const bool last = (t == nt - 2);
            const char* a1 = cA + (size_t)(t + 1) * kstep;
            const char* a2 = last ? nA : cA + (size_t)(t + 2) * kstep; const char* b2 = last ? nB : cB + (size_t)(t + 2) * kstep;
            const char* a3 = a2 + kstep; const char* b3 = b2 + kstep;
            PG8_LDB(B0, 0, 0); PG8_LDB(B1, 0, 1); PG8_SCHED; PG8_LDA(At, 0, 0); PG8_STAGE(PG8_SA(1, 1), a1 + hstep, voffA);
            PG8_WAIT_V(8); PG8_WAIT_L(0); PG8_BAR; PG8_MMA(0, 0, At, B0); PG8_MMA(0, 1, At, B1); PG8_BAR; PG8_SCHED;
            PG8_LDA(At, 0, 1); PG8_STAGE(PG8_SB(0, 0), b2, voffB); PG8_STAGE(PG8_SB(0, 1), b2 + hstep, voffB); PG8_STAGE(PG8_SA(0, 0), a2, voffA);
            PG8_WAIT_V(8); PG8_WAIT_L(0); PG8_BAR; PG8_MMA(1, 0, At, B0); PG8_MMA(1, 1, At, B1); PG8_BAR; PG8_SCHED;
            PG8_LDB(B0, 1, 0); PG8_LDB(B1, 1, 1); PG8_SCHED; PG8_LDA(At, 1, 0); PG8_STAGE(PG8_SA(0, 1), a2 + hstep, voffA);
            PG8_WAIT_V(8); PG8_WAIT_L(0); PG8_BAR; PG8_MMA(0, 0, At, B0); PG8_MMA(0, 1, At, B1); PG8_BAR; PG8_SCHED;
            PG8_LDA(At, 1, 1); PG8_STAGE(PG8_SB(1, 0), b3, voffB); PG8_STAGE(PG8_SB(1, 1), b3 + hstep, voffB); PG8_STAGE(PG8_SA(1, 0), a3, voffA);
            PG8_WAIT_V(8); PG8_WAIT_L(0); PG8_BAR; PG8_MMA(1, 0, At, B0); PG8_MMA(1, 1, At, B1); PG8_BAR; PG8_SCHED;
        }
        if constexpr (ALIGN_EPI) { if (wr == 0) PG8_BAR; }
        E(acc, cur, wr, wc, fr, fq);
        if (!has_next) break;
#pragma unroll
        for (int a = 0; a < 2; ++a)
#pragma unroll
            for (int b = 0; b < 2; ++b)
#pragma unroll
                for (int m = 0; m < 4; ++m)
#pragma unroll
                    for (int n = 0; n < 2; ++n) acc[a][b][m][n] = (f32x4){0.f, 0.f, 0.f, 0.f};
        cur = nxt; cA = nA; cB = nB; ++ui;
        if constexpr (ALIGN_EPI) { if (wr == 1) PG8_BAR; }
    }
    PG8_WAIT_V(0);
    if constexpr (!ALIGN_EPI) { if (wr == 0) PG8_BAR; }
    PG8_BAR;
#undef PG8_SA
#undef PG8_SB
#undef PG8_STAGE
#undef PG8_LDA
#undef PG8_LDB
#undef PG8_MMA
#undef PG8_WAIT_V
#undef PG8_WAIT_L
#undef PG8_BAR
#undef PG8_SCHED
}
}

constexpr int LAST_PM = MPR / 256;

struct EpiSwiglu {
    static constexpr bool PERM = true;
    bf16_t* H; const float* rowss;
    __device__ __forceinline__ void operator()(const f32x4 (&acc)[2][2][4][2], const pg8::Unit& u, int wr, int wc, int fr, int fq) const {
        const int row0 = u.pm * 256 + wr * 64 + fr, col0 = u.pn * 128 + wc * 32 + 8 * fq;
        const int nai = (u.pm == LAST_PM) ? 1 : 2;
#pragma unroll
        for (int ai = 0; ai < 2; ++ai) { if (ai < nai) {
#pragma unroll
            for (int m = 0; m < 4; ++m) {
                const int r = row0 + ai * 128 + m * 16;
                const float rs = __builtin_amdgcn_rsqf(rowss[r] * (1.0f / D) + EPS);
                float h[8];
#pragma unroll
                for (int n = 0; n < 2; ++n)
#pragma unroll
                    for (int j = 0; j < 4; ++j) { const float gv = acc[ai][0][m][n][j] * rs, uv = acc[ai][1][m][n][j] * rs; h[n * 4 + j] = siluf_(gv) * uv; }
                u32x4 w; w.x = cvt_pk_bf16(h[0], h[1]); w.y = cvt_pk_bf16(h[2], h[3]); w.z = cvt_pk_bf16(h[4], h[5]); w.w = cvt_pk_bf16(h[6], h[7]);
                *(u32x4*)(H + (size_t)r * FF + col0) = w;
            }
        } }
    }
};

struct EpiResid {
    static constexpr bool PERM = false;
    const float* baseP; const float* baseS; float* out; bf16_t* HB; float* rowss_next; float scale;
    __device__ __forceinline__ void operator()(const f32x4 (&acc)[2][2][4][2], const pg8::Unit& u, int wr, int wc, int fr, int fq) const {
        const int row0 = u.pm * 256 + wr * 64 + fr, col0 = u.pn * 256 + wc * 32 + 4 * fq;
        const int nai = (u.pm == LAST_PM) ? 1 : 2;
#pragma unroll
        for (int ai = 0; ai < 2; ++ai) { if (ai < nai) {
#pragma unroll
            for (int m = 0; m < 4; ++m) {
                const int r = row0 + ai * 128 + m * 16;
                const float* b = (r < MPR) ? baseP + (size_t)r * D : baseS + (size_t)(r - MPR) * D;
                float ss = 0.f;
#pragma unroll
                for (int bj = 0; bj < 2; ++bj)
#pragma unroll
                    for (int n = 0; n < 2; ++n) {
                        const int c = col0 + bj * 128 + n * 16;
                        const f32x4 bs = *(const f32x4*)(b + c);
                        const f32x4 a = acc[ai][bj][m][n];
                        const f32x4 o = bs + a * scale;
                        *(f32x4*)(out + (size_t)r * D + c) = o;
                        ss += (o[0] * o[0] + o[1] * o[1]) + (o[2] * o[2] + o[3] * o[3]);
                        u32x2 w; w.x = cvt_pk_bf16(o[0], o[1]); w.y = cvt_pk_bf16(o[2], o[3]);
                        *(u32x2*)(HB + (size_t)r * D + c) = w;
                    }
                ss += __shfl_xor(ss, 16); ss += __shfl_xor(ss, 32);
                if (fq == 0) atomicAdd(rowss_next + r, ss);
            }
        } }
    }
};

struct EpiMixIn {
    static constexpr bool PERM = true;
    bf16_t* UG; const float* rowss; const float* bin; float* vsum; float* ncp; int l;
    __device__ __forceinline__ void operator()(const f32x4 (&acc)[2][2][4][2], const pg8::Unit& u, int wr, int wc, int fr, int fq) const {
        const int row0 = u.pm * 256 + wr * 64 + fr;
        const int nai = (u.pm == LAST_PM) ? 1 : 2;
        const int type = u.pn >> 3;
        bf16_t* const GV = UG + (size_t)MPAD * D; bf16_t* const XG = GV + (size_t)MPAD * D; bf16_t* const BS = XG + (size_t)MPAD * D;
        float* const vsq = vsum + MPAD; float* const ncs = ncp + (O_NCS - O_NCP) + (size_t)l * (NS - NB) * 2 * D;
        if (type < 3) {
            const int col0 = (u.pn & 7) * 128 + wc * 32 + 8 * fq;
            const int o0 = type == 0 ? 0 : (type == 1 ? 3072 : 2048), o1 = type == 0 ? 5120 : (type == 1 ? 4096 : 6144);
            bf16_t* O = type == 0 ? UG : (type == 1 ? XG : BS);
            const f32x4 b00 = *(const f32x4*)(bin + o0 + col0), b01 = *(const f32x4*)(bin + o0 + col0 + 4);
            const f32x4 b10 = *(const f32x4*)(bin + o1 + col0), b11 = *(const f32x4*)(bin + o1 + col0 + 4);
#pragma unroll
            for (int ai = 0; ai < 2; ++ai) { if (ai < nai) {
#pragma unroll
                for (int m = 0; m < 4; ++m) {
                    const int r = row0 + ai * 128 + m * 16;
                    const float rs = __builtin_amdgcn_rsqf(rowss[r] * (1.0f / D) + EPS);
                    f32x4 p0 = acc[ai][0][m][0] * rs + b00, p1 = acc[ai][0][m][1] * rs + b01;
                    f32x4 q0 = acc[ai][1][m][0] * rs + b10, q1 = acc[ai][1][m][1] * rs + b11;
                    f32x4 r0, r1;
                    if (type == 0) { p0 = gelu4(p0); p1 = gelu4(p1);
#pragma unroll
                        for (int j = 0; j < 4; ++j) { r0[j] = p0[j] * sigmoidf_(q0[j]); r1[j] = p1[j] * sigmoidf_(q1[j]); } }
                    else if (type == 1) { r0 = p0 * q0; r1 = p1 * q1;
                        if (r < MPR) { const int t = r & (SEQ - 1); if (t >= SEQ - 2) { float* o = ncp + ((size_t)((r >> 11) * 2 + (t - (SEQ - 2)))) * D + col0; *(f32x4*)o = r0; *(f32x4*)(o + 4) = r1; } }
                        else { float* o = ncs + ((size_t)((r - MPR) * 2 + 1)) * D + col0; *(f32x4*)o = r0; *(f32x4*)(o + 4) = r1; } }
                    else {
#pragma unroll
                        for (int j = 0; j < 4; ++j) { r0[j] = p0[j] * sigmoidf_(q0[j]); r1[j] = p1[j] * sigmoidf_(q1[j]); } }
                    u32x4 w; w.x = cvt_pk_bf16(r0[0], r0[1]); w.y = cvt_pk_bf16(r0[2], r0[3]); w.z = cvt_pk_bf16(r1[0], r1[1]); w.w = cvt_pk_bf16(r1[2], r1[3]);
                    *(u32x4*)(O + (size_t)r * D + col0) = w;
                }
            } }
        } else {
            const int col0 = (u.pn - 24) * 256 + wc * 32 + 8 * fq;
            f32x4 bv[2][2];
#pragma unroll
            for (int bj = 0; bj < 2; ++bj)
#pragma unroll
                for (int n = 0; n < 2; ++n) bv[bj][n] = *(const f32x4*)(bin + 1024 + col0 + bj * 128 + 4 * n);
#pragma unroll
            for (int ai = 0; ai < 2; ++ai) { if (ai < nai) {
#pragma unroll
                for (int m = 0; m < 4; ++m) {
                    const int r = row0 + ai * 128 + m * 16;
                    const float rs = __builtin_amdgcn_rsqf(rowss[r] * (1.0f / D) + EPS);
                    float s1 = 0.f, s2 = 0.f;
#pragma unroll
                    for (int bj = 0; bj < 2; ++bj) {
                        f32x4 v0 = gelu4(acc[ai][bj][m][0] * rs + bv[bj][0]), v1 = gelu4(acc[ai][bj][m][1] * rs + bv[bj][1]);
                        s1 += (v0[0] + v0[1]) + (v0[2] + v0[3]) + (v1[0] + v1[1]) + (v1[2] + v1[3]);
                        s2 += (v0[0] * v0[0] + v0[1] * v0[1]) + (v0[2] * v0[2] + v0[3] * v0[3]) + (v1[0] * v1[0] + v1[1] * v1[1]) + (v1[2] * v1[2] + v1[3] * v1[3]);
                        u32x4 w; w.x = cvt_pk_bf16(v0[0], v0[1]); w.y = cvt_pk_bf16(v0[2], v0[3]); w.z = cvt_pk_bf16(v1[0], v1[1]); w.w = cvt_pk_bf16(v1[2], v1[3]);
                        *(u32x4*)(GV + (size_t)r * D + col0 + bj * 128) = w;
                    }
                    s1 += __shfl_xor(s1, 16); s1 += __shfl_xor(s1, 32); s2 += __shfl_xor(s2, 16); s2 += __shfl_xor(s2, 32);
                    if (fq == 0) { atomicAdd(vsum + r, s1); atomicAdd(vsq + r, s2); }
                }
            } }
        }
    }
};

struct Args { const float* in[21]; float* out; unsigned char* ws; };
typedef const __attribute__((address_space(4))) Args* KArgs;
__device__ __forceinline__ KArgs kargs() { KArgs p = (KArgs)__builtin_amdgcn_kernarg_segment_ptr(); asm volatile("" : "+s"(p)); return p; }
enum { I_XP = 0, I_XS, I_STATE, I_F1N, I_F1G, I_F1U, I_F1D, I_MIXN, I_WIN, I_BIN, I_VG, I_VB, I_WSP, I_BSP, I_CW, I_WO, I_F2N, I_F2G, I_F2U, I_F2D, I_FN };

__device__ __forceinline__ void transpose_item(const float* W, int N, int srccol0, const float* gain, bf16_t* WT, int K, int destrow0, int k0, LAS float* scr, int lane) {
#pragma unroll 8
    for (int i = 0; i < 32; ++i) { const int kk = 2 * i + (lane >> 5); const float gsc = gain ? gain[k0 + kk] : 1.0f; scr[kk * 33 + (lane & 31)] = W[(size_t)(k0 + kk) * N + srccol0 + (lane & 31)] * gsc; }
    asm volatile("s_waitcnt lgkmcnt(0)" ::: "memory");
    const int c = lane & 7;
#pragma unroll
    for (int j = 0; j < 4; ++j) { const int n = (lane >> 3) + 8 * j; const LAS float* s = scr + (8 * c) * 33 + n;
        u32x4 o; o.x = cvt_pk_bf16(s[0 * 33], s[1 * 33]); o.y = cvt_pk_bf16(s[2 * 33], s[3 * 33]); o.z = cvt_pk_bf16(s[4 * 33], s[5 * 33]); o.w = cvt_pk_bf16(s[6 * 33], s[7 * 33]);
        *(u32x4*)(WT + (size_t)(destrow0 + n) * K + k0 + 8 * c) = o; }
    asm volatile("s_waitcnt lgkmcnt(0)" ::: "memory");
}
__device__ __forceinline__ int win_srccol(int nprime) {
    const int pn = nprime >> 8, w = nprime & 255, half = w >> 7, cw = w & 127;
    if (pn < 8) return (half ? 5120 : 0) + 128 * pn + cw;
    if (pn < 16) return (half ? 4096 : 3072) + 128 * (pn - 8) + cw;
    if (pn < 24) return (half ? 6144 : 2048) + 128 * (pn - 16) + cw;
    return 1024 + 256 * (pn - 24) + w;
}
constexpr int IT_W1 = 16 * 176, IT_W2 = 44 * 32, IT_WIN = 16 * 224, IT_WO = 16 * 32, IT_LAYER = 2 * IT_W1 + 2 * IT_W2 + IT_WIN + IT_WO;

__device__ __forceinline__ void prologue(KArgs a, LAS unsigned char* lds) {
    const int tid = threadIdx.x, lane = tid & 63, wave = tid >> 6;
    const int gw = blockIdx.x * 8 + wave, NGW = gridDim.x * 8;
    float* stat = (float*)(a->ws + WS_STAT);
    for (size_t i = (size_t)blockIdx.x * 512 + tid; i < (size_t)10 * MPAD; i += (size_t)gridDim.x * 512) stat[MPAD + i] = 0.f;
    if (blockIdx.x == 0 && tid < MPAD - M) stat[M + tid] = 0.f;
    bf16_t* HB = (bf16_t*)(a->ws + WS_HB);
    for (int r = gw; r < M; r += NGW) {
        const float* xr = (r < MPR) ? a->in[I_XP] + (size_t)r * D : a->in[I_XS] + (size_t)(r - MPR) * D;
        const f32x4* x4 = (const f32x4*)xr + lane;
        unsigned long long* o8 = (unsigned long long*)(HB + (size_t)r * D) + lane;
        float s = 0.f;
#pragma unroll
        for (int j = 0; j < 4; ++j) { const f32x4 v = x4[64 * j]; s += (v[0] * v[0] + v[1] * v[1]) + (v[2] * v[2] + v[3] * v[3]);
            o8[64 * j] = (unsigned long long)cvt_pk_bf16(v[0], v[1]) | ((unsigned long long)cvt_pk_bf16(v[2], v[3]) << 32); }
        s = wave_sum(s);
        if (lane == 0) stat[r] = s;
    }
    for (int i = blockIdx.x * 512 + tid; i < DEPTH * NS * (D / 4); i += gridDim.x * 512) {
        const int ls = i / (D / 4), c4 = i % (D / 4);
        *((f32x4*)(a->out + O_NCS + (size_t)(ls * 2) * D) + c4) = *((const f32x4*)(a->in[I_STATE] + (size_t)(ls * 2 + 1) * D) + c4);
    }
    LAS float* scr = (LAS float*)(lds + wave * 16384);
    for (int it = gw; it < DEPTH * IT_LAYER; it += NGW) {
        const int l = it / IT_LAYER; int r = it % IT_LAYER;
        bf16_t* WL = (bf16_t*)(a->ws + WS_W) + (size_t)l * LAYER_W_ELEMS;
        if (r < 2 * IT_W1) {
            const int which = r / IT_W1; r %= IT_W1; const int kb = r / 176, nb = r % 176, np = 32 * nb, pn = np >> 8, w = np & 255, half = w >> 7, cw = w & 127;
            const float* src = a->in[which ? (half ? I_F2U : I_F2G) : (half ? I_F1U : I_F1G)] + (size_t)l * D * FF;
            transpose_item(src, FF, 128 * pn + cw, a->in[which ? I_F2N : I_F1N] + l * D, WL + (which ? OW6 : OW1), D, np, 64 * kb, scr, lane);
            continue; }
        r -= 2 * IT_W1;
        if (r < 2 * IT_W2) {
            const int which = r / IT_W2; r %= IT_W2; const int kb = r / 32, nb = r % 32;
            transpose_item(a->in[which ? I_F2D : I_F1D] + (size_t)l * FF * D, D, 32 * nb, nullptr, WL + (which ? OW7 : OW2), FF, 32 * nb, 64 * kb, scr, lane);
            continue; }
        r -= 2 * IT_W2;
        if (r < IT_WIN) { const int kb = r / 224, nb = r % 224;
            transpose_item(a->in[I_WIN] + (size_t)l * D * NIN, NIN, win_srccol(32 * nb), a->in[I_MIXN] + l * D, WL + OWIN, D, 32 * nb, 64 * kb, scr, lane);
            continue; }
        r -= IT_WIN;
        { const int kb = r / 32, nb = r % 32;
            transpose_item(a->in[I_WO] + (size_t)l * D * D, D, 32 * nb, nullptr, WL + OWO, D, 32 * nb, 64 * kb, scr, lane); }
    }
}

constexpr int TROW = 272;
constexpr int T_OFF = 0, W_OFF = 256 * TROW, ST_OFF = W_OFF + 128 * TROW;
__device__ __forceinline__ void mix_prompt_item(KArgs a, LAS unsigned char* lds, int l, int chunk, int g) {
    int tid_ = threadIdx.x; asm volatile("" : "+v"(tid_));
    const int tid = tid_, lane = tid & 63, wave = __builtin_amdgcn_readfirstlane(tid >> 6), fr = lane & 15, fq = lane >> 4;
    float* stat = (float*)(a->ws + WS_STAT);
    const float* vsum = stat + (size_t)(7 + 2 * l) * MPAD; const float* vsq = vsum + MPAD;
    bf16_t* UG = (bf16_t*)(a->ws + WS_R); const bf16_t* GV = UG + (size_t)MPAD * D; const bf16_t* XG = GV + (size_t)MPAD * D; const bf16_t* BS = XG + (size_t)MPAD * D;
    const int row0 = chunk * 128;
    LAS float* st = (LAS float*)(lds + ST_OFF);
    if (tid < 128) { const int r = row0 + tid; const float mean = vsum[r] * (1.0f / D); const float var = fmaxf(vsq[r] * (1.0f / D) - mean * mean, 0.f);
        st[2 * tid] = mean; st[2 * tid + 1] = __builtin_amdgcn_rsqf(var + EPS); }
    {
        const int t = tid >> 2, s0 = (tid & 3) * 32; const float* wp = a->in[I_WSP] + ((size_t)(l * 4 + g) * 128 + t) * 128 + s0;
#pragma unroll
        for (int q = 0; q < 4; ++q) { const f32x4 w0 = *(const f32x4*)(wp + 8 * q), w1 = *(const f32x4*)(wp + 8 * q + 4); float e[8] = {w0[0], w0[1], w0[2], w0[3], w1[0], w1[1], w1[2], w1[3]};
#pragma unroll
            for (int j = 0; j < 8; ++j) e[j] = (s0 + 8 * q + j <= t) ? e[j] : 0.f;
            u32x4 o; o.x = cvt_pk_bf16(e[0], e[1]); o.y = cvt_pk_bf16(e[2], e[3]); o.z = cvt_pk_bf16(e[4], e[5]); o.w = cvt_pk_bf16(e[6], e[7]);
            *(LAS u32x4*)(lds + W_OFF + t * TROW + (s0 + 8 * q) * 2) = o; }
    }
    __syncthreads();
    {
        const float* vg = a->in[I_VG] + l * D + 256 * g; const float* vb = a->in[I_VB] + l * D + 256 * g;
#pragma unroll 2
        for (int i = 0; i < 8; ++i) { const int idx = i * 512 + tid, s = idx & 127, d = (idx >> 7) * 8;
            const u32x4 x = *(const u32x4*)(GV + (size_t)(row0 + s) * D + 256 * g + d);
            const float mean = st[2 * s], rstd = st[2 * s + 1];
            const f32x4 g0 = *(const f32x4*)(vg + d), g1 = *(const f32x4*)(vg + d + 4), c0 = *(const f32x4*)(vb + d), c1 = *(const f32x4*)(vb + d + 4);
            float e[8] = {bf_lo(x.x), bf_hi(x.x), bf_lo(x.y), bf_hi(x.y), bf_lo(x.z), bf_hi(x.z), bf_lo(x.w), bf_hi(x.w)};
            const float gg[8] = {g0[0], g0[1], g0[2], g0[3], g1[0], g1[1], g1[2], g1[3]}; const float cc[8] = {c0[0], c0[1], c0[2], c0[3], c1[0], c1[1], c1[2], c1[3]};
#pragma unroll
            for (int j = 0; j < 8; ++j) { const float v = (e[j] - mean) * rstd * gg[j] + cc[j]; *(LAS bf16_t*)(lds + T_OFF + (d + j) * TROW + s * 2) = (bf16_t)(cvt_pk_bf16(v, 0.f) & 0xffffu); }
        }
    }
    __syncthreads();
    f32x4 acc[16];
#pragma unroll
    for (int n = 0; n < 16; ++n) acc[n] = (f32x4){0.f, 0.f, 0.f, 0.f};
    const int kmax = (16 * wave + 15) >> 5;
    for (int ks = 0; ks <= kmax; ++ks) {
        const bf16x8 af = *(const LAS bf16x8*)(lds + W_OFF + (16 * wave + fr) * TROW + (32 * ks + 8 * fq) * 2);
#pragma unroll
        for (int n = 0; n < 16; ++n) { const bf16x8 bfr = *(const LAS bf16x8*)(lds + T_OFF + (16 * n + fr) * TROW + (32 * ks + 8 * fq) * 2);
            acc[n] = __builtin_amdgcn_mfma_f32_16x16x32_bf16(bfr, af, acc[n], 0, 0, 0); }
    }
    {
        const int t = 16 * wave + fr, r = row0 + t, tseq = r & (SEQ - 1);
        const float bsp = a->in[I_BSP][(l * 4 + g) * 128 + t];
        const float* cw = a->in[I_CW] + (size_t)l * 3 * D;
#pragma unroll
        for (int n = 0; n < 16; ++n) { if ((n & 1) == 0) asm volatile("" ::: "memory");
            const int d = 256 * g + 16 * n + 4 * fq; const size_t off = (size_t)r * D + d;
            const u32x2 ug = *(const u32x2*)(UG + off), bs = *(const u32x2*)(BS + off), x0 = *(const u32x2*)(XG + off);
            u32x2 x1 = (u32x2){0u, 0u}, x2 = (u32x2){0u, 0u};
            if (tseq >= 1) x1 = *(const u32x2*)(XG + off - D);
            if (tseq >= 2) x2 = *(const u32x2*)(XG + off - 2 * D);
            const f32x4 w0 = *(const f32x4*)(cw + d), w1 = *(const f32x4*)(cw + D + d), w2 = *(const f32x4*)(cw + 2 * D + d);
            const float ugf[4] = {bf_lo(ug.x), bf_hi(ug.x), bf_lo(ug.y), bf_hi(ug.y)}, bsf[4] = {bf_lo(bs.x), bf_hi(bs.x), bf_lo(bs.y), bf_hi(bs.y)};
            const float x0f[4] = {bf_lo(x0.x), bf_hi(x0.x), bf_lo(x0.y), bf_hi(x0.y)}, x1f[4] = {bf_lo(x1.x), bf_hi(x1.x), bf_lo(x1.y), bf_hi(x1.y)}, x2f[4] = {bf_lo(x2.x), bf_hi(x2.x), bf_lo(x2.y), bf_hi(x2.y)};
            float mo[4];
#pragma unroll
            for (int j = 0; j < 4; ++j) mo[j] = ugf[j] * (acc[n][j] + bsp) + bsf[j] * (w0[j] * x2f[j] + w1[j] * x1f[j] + w2[j] * x0f[j]);
            u32x2 o; o.x = cvt_pk_bf16(mo[0], mo[1]); o.y = cvt_pk_bf16(mo[2], mo[3]);
            *(u32x2*)(UG + off) = o; }
    }
    __syncthreads();
}
__device__ __forceinline__ void mix_sample_item(KArgs a, int l, int g) {
    const int tid = threadIdx.x;
    float* stat = (float*)(a->ws + WS_STAT);
    const float* vsum = stat + (size_t)(7 + 2 * l) * MPAD; const float* vsq = vsum + MPAD;
    bf16_t* UG = (bf16_t*)(a->ws + WS_R); const bf16_t* GV = UG + (size_t)MPAD * D; const bf16_t* XG = GV + (size_t)MPAD * D; const bf16_t* BS = XG + (size_t)MPAD * D;
    const float w00 = a->in[I_WSP][(size_t)(l * 4 + g) * 128 * 128], b0 = a->in[I_BSP][(l * 4 + g) * 128];
    const float* cw = a->in[I_CW] + (size_t)l * 3 * D;
    for (int i = 0; i < 8; ++i) { const int idx = i * 512 + tid, s = idx >> 5, d = 256 * g + (idx & 31) * 8; const int r = MPR + s; const size_t off = (size_t)r * D + d;
        const float mean = vsum[r] * (1.0f / D); const float var = fmaxf(vsq[r] * (1.0f / D) - mean * mean, 0.f); const float rstd = __builtin_amdgcn_rsqf(var + EPS);
        const u32x4 gv = *(const u32x4*)(GV + off), ug = *(const u32x4*)(UG + off), bs = *(const u32x4*)(BS + off), xg = *(const u32x4*)(XG + off);
        const float gvf[8] = {bf_lo(gv.x), bf_hi(gv.x), bf_lo(gv.y), bf_hi(gv.y), bf_lo(gv.z), bf_hi(gv.z), bf_lo(gv.w), bf_hi(gv.w)};
        const float ugf[8] = {bf_lo(ug.x), bf_hi(ug.x), bf_lo(ug.y), bf_hi(ug.y), bf_lo(ug.z), bf_hi(ug.z), bf_lo(ug.w), bf_hi(ug.w)};
        const float bsf[8] = {bf_lo(bs.x), bf_hi(bs.x), bf_lo(bs.y), bf_hi(bs.y), bf_lo(bs.z), bf_hi(bs.z), bf_lo(bs.w), bf_hi(bs.w)};
        const float xgf[8] = {bf_lo(xg.x), bf_hi(xg.x), bf_lo(xg.y), bf_hi(xg.y), bf_lo(xg.z), bf_hi(xg.z), bf_lo(xg.w), bf_hi(xg.w)};
        const float* st0 = a->in[I_STATE] + ((size_t)(l * NS + s) * 2) * D + d; const float* st1 = st0 + D;
        float* vo = a->out + O_VS + ((size_t)(l * NS + s)) * D + d;
        float mo[8];
#pragma unroll
        for (int j = 0; j < 8; ++j) { const float vp = (gvf[j] - mean) * rstd * a->in[I_VG][l * D + d + j] + a->in[I_VB][l * D + d + j]; vo[j] = vp;
            const float conv = cw[d + j] * st0[j] + cw[D + d + j] * st1[j] + cw[2 * D + d + j] * xgf[j];
            mo[j] = ugf[j] * (w00 * vp + b0) + bsf[j] * conv; }
        u32x4 o; o.x = cvt_pk_bf16(mo[0], mo[1]); o.y = cvt_pk_bf16(mo[2], mo[3]); o.z = cvt_pk_bf16(mo[4], mo[5]); o.w = cvt_pk_bf16(mo[6], mo[7]);
        *(u32x4*)(UG + off) = o; }
}

__global__ void __launch_bounds__(512, 2) fwd_megakernel(Args a_unused) {
    extern __shared__ __attribute__((aligned(16))) unsigned char lds_raw[];
    LAS unsigned char* lds = (LAS unsigned char*)lds_raw;
    cg::grid_group grid = cg::this_grid();
    const int G = gridDim.x, bid = blockIdx.x;

    prologue(kargs(), lds);
    grid.sync();
#pragma unroll 1
    for (int l = 0; l < DEPTH; ++l) {
        {
            KArgs p = kargs(); unsigned char* ws = p->ws;
            pg8::Gemm g{(const bf16_t*)(ws + WS_HB), (const bf16_t*)(ws + WS_W) + (size_t)l * LAYER_W_ELEMS + OW1, MPAD, 2 * FF, D}; pg8::StaticOrder S; S.init(MPAD, 2 * FF, G, bid);
            EpiSwiglu E{(bf16_t*)(ws + WS_R), (const float*)(ws + WS_STAT) + (size_t)(3 * l) * MPAD};
            pg8::gemm_phase<EpiSwiglu, true>(lds, g, S, E);
        }
        grid.sync();
        {
            KArgs p = kargs(); unsigned char* ws = p->ws; float* H = p->out;
            pg8::Gemm g{(const bf16_t*)(ws + WS_R), (const bf16_t*)(ws + WS_W) + (size_t)l * LAYER_W_ELEMS + OW2, MPAD, D, FF}; pg8::StaticOrder S; S.init(MPAD, D, G, bid);
            EpiResid E{l == 0 ? p->in[I_XP] : H, l == 0 ? p->in[I_XS] : H + (size_t)MPR * D, H, (bf16_t*)(ws + WS_HB), (float*)(ws + WS_STAT) + (size_t)(3 * l + 1) * MPAD, 0.5f};
            pg8::gemm_phase<EpiResid, true>(lds, g, S, E);
        }
        grid.sync();
        {
            KArgs p = kargs(); unsigned char* ws = p->ws;
            pg8::Gemm g{(const bf16_t*)(ws + WS_HB), (const bf16_t*)(ws + WS_W) + (size_t)l * LAYER_W_ELEMS + OWIN, MPAD, NIN, D}; pg8::StaticOrder S; S.init(MPAD, NIN, G, bid);
            EpiMixIn E{(bf16_t*)(ws + WS_R), (const float*)(ws + WS_STAT) + (size_t)(3 * l + 1) * MPAD, p->in[I_BIN] + (size_t)l * NIN, (float*)(ws + WS_STAT) + (size_t)(7 + 2 * l) * MPAD,
                       p->out + O_NCP + (size_t)l * NB * 2 * D, l};
            pg8::gemm_phase<EpiMixIn, true>(lds, g, S, E);
        }
        grid.sync();
        {
            KArgs p = kargs();
            for (int it = bid; it < 516; it += G) {
                if (it < 512) mix_prompt_item(p, lds, l, it >> 2, it & 3); else mix_sample_item(p, l, it - 512);
            }
        }
        grid.sync();
        {
            KArgs p = kargs(); unsigned char* ws = p->ws; float* H = p->out;
            pg8::Gemm g{(const bf16_t*)(ws + WS_R), (const bf16_t*)(ws + WS_W) + (size_t)l * LAYER_W_ELEMS + OWO, MPAD, D, D}; pg8::StaticOrder S; S.init(MPAD, D, G, bid);
            EpiResid E{H, H + (size_t)MPR * D, H, (bf16_t*)(ws + WS_HB), (float*)(ws + WS_STAT) + (size_t)(3 * l + 2) * MPAD, 1.0f};
            pg8::gemm_phase<EpiResid, true>(lds, g, S, E);
        }
        grid.sync();
        {
            KArgs p = kargs(); unsigned char* ws = p->ws;
            pg8::Gemm g{(const bf16_t*)(ws + WS_HB), (const bf16_t*)(ws + WS_W) + (size_t)l * LAYER_W_ELEMS + OW6, MPAD, 2 * FF, D}; pg8::StaticOrder S; S.init(MPAD, 2 * FF, G, bid);
            EpiSwiglu E{(bf16_t*)(ws + WS_R), (const float*)(ws + WS_STAT) + (size_t)(3 * l + 2) * MPAD};
            pg8::gemm_phase<EpiSwiglu, true>(lds, g, S, E);
        }
        grid.sync();
        {
            KArgs p = kargs(); unsigned char* ws = p->ws; float* H = p->out;
            pg8::Gemm g{(const bf16_t*)(ws + WS_R), (const bf16_t*)(ws + WS_W) + (size_t)l * LAYER_W_ELEMS + OW7, MPAD, D, FF}; pg8::StaticOrder S; S.init(MPAD, D, G, bid);
            EpiResid E{H, H + (size_t)MPR * D, H, (bf16_t*)(ws + WS_HB), (float*)(ws + WS_STAT) + (size_t)(3 * l + 3) * MPAD, 0.5f};
            pg8::gemm_phase<EpiResid, true>(lds, g, S, E);
        }
        grid.sync();
    }
    {
        KArgs p = kargs();
        const int tid = threadIdx.x, lane = tid & 63, wave = tid >> 6;
        const float* rsf = (const float*)(p->ws + WS_STAT) + (size_t)6 * MPAD;
        const f32x4* fn4 = (const f32x4*)p->in[I_FN] + lane;
        float* H = p->out;
        for (int r = bid * 8 + wave; r < M; r += G * 8) {
            const float rs = __builtin_amdgcn_rsqf(rsf[r] * (1.0f / D) + EPS);
            f32x4* y = (f32x4*)(H + (size_t)r * D) + lane;
#pragma unroll
            for (int j = 0; j < 4; ++j) y[64 * j] = y[64 * j] * rs * fn4[64 * j];
        }
    }
}

extern "C" void kernel_launch(void* const* d_in, const int* in_sizes, int n_in, void* d_out, int out_size, void* d_ws, size_t ws_size, hipStream_t stream) {
    static int grid = 0;
    if (grid == 0) {
        if (n_in != 21 || ws_size < WS_END) { fprintf(stderr, "kernel_launch: bad setup n_in %d ws %zu (need %zu)\n", n_in, ws_size, (size_t)WS_END); grid = -1; return; }
        int dev = 0, cus = 0, per_cu = 0;
        (void)hipGetDevice(&dev);
        (void)hipDeviceGetAttribute(&cus, hipDeviceAttributeMultiprocessorCount, dev);
        (void)hipFuncSetAttribute((const void*)fwd_megakernel, hipFuncAttributeMaxDynamicSharedMemorySize, LDS_BYTES);
        (void)hipOccupancyMaxActiveBlocksPerMultiprocessor(&per_cu, (const void*)fwd_megakernel, 512, LDS_BYTES);
        if (per_cu < 1) per_cu = 1;
        grid = cus * per_cu;
        (void)hipGetLastError();
    }
    if (grid < 0) return;
    Args a{};
    for (int i = 0; i < 21; ++i) a.in[i] = (const float*)d_in[i];
    a.out = (float*)d_out; a.ws = (unsigned char*)d_ws;
    void* args[] = {&a};
    hipError_t e = hipLaunchCooperativeKernel((const void*)fwd_megakernel, dim3(grid), dim3(512), args, LDS_BYTES, stream);
    if (e != hipSuccess) fprintf(stderr, "cooperative launch failed: %s (grid %d)\n", hipGetErrorString(e), grid);
}
```

```cpp
#include <hip/hip_runtime.h>
#include <hip/hip_cooperative_groups.h>
#include <cstdio>
#include <cstdint>
namespace cg = cooperative_groups;

#define LAS __attribute__((address_space(3)))
typedef unsigned short bf16_t;
typedef short bf16x8 __attribute__((ext_vector_type(8)));
typedef float f32x4 __attribute__((ext_vector_type(4)));
typedef float f32x2 __attribute__((ext_vector_type(2)));
typedef unsigned u32x4 __attribute__((ext_vector_type(4)));
typedef unsigned u32x2 __attribute__((ext_vector_type(2)));

constexpr int D = 1024, FF = 2816, NIN = 7168, SEQ = 2048, NB = 8, NS = 128, DEPTH = 2;
constexpr int MPR = NB * SEQ;
constexpr int M = MPR + NS;
constexpr int MPAD = 16640;
constexpr float EPS = 1e-6f;
constexpr size_t O_Y = 0, O_NCP = (size_t)M * D, O_NCS = O_NCP + (size_t)DEPTH * NB * 2 * D, O_VS = O_NCS + (size_t)DEPTH * NS * 2 * D;
constexpr size_t MiB = 1u << 20;
constexpr size_t WS_STAT = 0;
constexpr size_t WS_BAR = 768 * 1024, BAR_BYTES = 16384;
constexpr size_t WS_W = 1 * MiB;
constexpr size_t LAYER_W_ELEMS = 25690112;
constexpr size_t OW1 = 0, OW2 = 5767168, OWIN = 8650752, OWO = 15990784, OW6 = 17039360, OW7 = 22806528;
constexpr size_t WS_HB = 99 * MiB;
constexpr size_t ACT_BYTES = (size_t)MPAD * D * 2;
constexpr size_t WS_R = WS_HB + ACT_BYTES;
constexpr size_t WS_END = WS_R + 4 * ACT_BYTES;
constexpr int LDS_BYTES = 147456;

__device__ __forceinline__ unsigned cvt_pk_bf16(float lo, float hi) { unsigned r; asm("v_cvt_pk_bf16_f32 %0, %1, %2" : "=v"(r) : "v"(lo), "v"(hi)); return r; }
__device__ __forceinline__ float bf_lo(unsigned w) { return __uint_as_float(w << 16); }
__device__ __forceinline__ float bf_hi(unsigned w) { return __uint_as_float(w & 0xffff0000u); }
__device__ __forceinline__ float sigmoidf_(float x) { return __builtin_amdgcn_rcpf(1.0f + __builtin_amdgcn_exp2f(-1.44269504089f * x)); }
__device__ __forceinline__ float siluf_(float x) { return x * sigmoidf_(x); }
__device__ __forceinline__ f32x2 gelu_pk(f32x2 v) {
    const f32x2 av = __builtin_elementwise_abs(v), d = av * 0.2316418882f + 1.0f;
    f32x2 t; t.x = __builtin_amdgcn_rcpf(d.x); t.y = __builtin_amdgcn_rcpf(d.y);
    f32x2 q = t * 0.5307027145f + (-0.7265760135f); q = q * t + 0.7107068705f; q = q * t + (-0.142248368f); q = q * t + 0.127414796f; q = q * t;
    const f32x2 s = (v * v) * (-0.72134752044f);
    f32x2 e; e.x = __builtin_amdgcn_exp2f(s.x); e.y = __builtin_amdgcn_exp2f(s.y);
    const f32x2 m = v * (q * e), r = v - m;
    f32x2 o; o.x = v.x < 0.f ? m.x : r.x; o.y = v.y < 0.f ? m.y : r.y; return o;
}
__device__ __forceinline__ f32x4 gelu4(f32x4 v) { f32x2 a = gelu_pk((f32x2){v[0], v[1]}), b = gelu_pk((f32x2){v[2], v[3]}); return (f32x4){a.x, a.y, b.x, b.y}; }
__device__ __forceinline__ float wave_sum(float v) {
#pragma unroll
    for (int o = 1; o < 64; o <<= 1) v += __shfl_xor(v, o);
    return v;
}

namespace pg8 {
constexpr int BM = 256, BK = 64, HALF = 128, HTB = HALF * BK * 2, STAGE_BYTES = 8 * HTB, NXCD = 8, WGM = 8;
__host__ __device__ __forceinline__ int lds_byte(int r, int c) { const int st = (r >> 4) * 2 + (c >> 5), rr = r & 15, cc = c & 31, ob = rr * 64 + cc * 2; return st * 1024 + (ob ^ (((ob >> 9) & 1) << 5)); }
__host__ __device__ __forceinline__ void stage_rc(int b, int& R, int& C) { const int st = b / 1024, sb = b % 1024, swz = sb ^ (((sb >> 9) & 1) << 5); R = (st >> 1) * 16 + swz / 64; C = (st & 1) * 32 + (swz % 64) / 2; }
__host__ __device__ __forceinline__ int perm32(int rho) { const int n = rho >> 4, i = rho & 15; return 8 * (i >> 2) + 4 * n + (i & 3); }
struct Unit { int pm, pn; };
struct Gemm { const bf16_t* A; const bf16_t* Bt; int M, N, K; };
struct StaticOrder {
    int nM, nN, nwg, G, c;
    __device__ void init(int M_, int N_, int G_, int c_) { nM = M_ / BM; nN = N_ / BM; nwg = nM * nN; G = G_; c = c_; }
    __device__ bool next(int i, Unit& u) const {
        const long L = (long)i * G + c; if (L >= nwg) return false;
        int wgid = (int)L; { const int q = nwg / NXCD, r = nwg % NXCD, xcd = wgid % NXCD, off = wgid / NXCD; wgid = (xcd < r ? xcd * (q + 1) : r * (q + 1) + (xcd - r) * q) + off; }
        const int nig = WGM * nN, gid = wgid / nig, fm = gid * WGM, gsz = (nM - fm) < WGM ? (nM - fm) : WGM;
        u.pm = fm + ((wgid % nig) % gsz); u.pn = (wgid % nig) / gsz; return true;
    }
};

template <class Epi, bool ALIGN_EPI>
__device__ __forceinline__ void gemm_phase(LAS unsigned char* lds, const Gemm g, const StaticOrder& S, const Epi& E) {
    int tid_ = threadIdx.x; asm volatile("" : "+v"(tid_));
    const int tid = tid_, wid = __builtin_amdgcn_readfirstlane(tid >> 6), lane = tid & 63, wr = wid >> 2, wc = wid & 3, fr = lane & 15, fq = lane >> 4;
    const int K = g.K, nt = K / BK;
    unsigned voffA[2], voffB[2];
#pragma unroll
    for (int i = 0; i < 2; ++i) { int R, C; stage_rc(tid * 16 + i * 8192, R, C); const int Rb = Epi::PERM ? ((R & ~31) + perm32(R & 31)) : R;
        voffA[i] = (unsigned)(R * K + C) * 2u; voffB[i] = (unsigned)(Rb * K + C) * 2u; }
    const size_t kstep = (size_t)(BK * 2);
    const size_t hstep = (size_t)HALF * K * 2;
    const size_t tstep = 2 * hstep;
    const unsigned ldsw = (unsigned)wid * 1024u;
    const int aoff = lds_byte(wr * 64 + fr, fq * 8), boff = lds_byte(wc * 32 + fr, fq * 8);
#define PG8_SA(b, h) (((b) * 2 + (h)) * HTB)
#define PG8_SB(b, h) ((4 + (b) * 2 + (h)) * HTB)
#define PG8_STAGE(bufoff, gbase, voff) do { _Pragma("unroll") for (int _i = 0; _i < 2; ++_i) \
        __builtin_amdgcn_global_load_lds((const unsigned*)((const char*)(gbase) + (voff)[_i]), (LAS unsigned*)(lds + (bufoff) + ldsw + _i * 8192), 16, 0, 0); } while (0)
#define PG8_LDA(dst, b, h) do { _Pragma("unroll") for (int m = 0; m < 4; ++m) _Pragma("unroll") for (int k = 0; k < 2; ++k) dst[m][k] = *(const LAS bf16x8*)(lds + PG8_SA(b, h) + aoff + m * 2048 + k * 1024); } while (0)
#define PG8_LDB(dst, b, h) do { _Pragma("unroll") for (int n = 0; n < 2; ++n) _Pragma("unroll") for (int k = 0; k < 2; ++k) dst[n][k] = *(const LAS bf16x8*)(lds + PG8_SB(b, h) + boff + n * 2048 + k * 1024); } while (0)
#define PG8_MMA(ai, bj, At, Bt) do { __builtin_amdgcn_s_setprio(1); _Pragma("unroll") for (int m = 0; m < 4; ++m) _Pragma("unroll") for (int n = 0; n < 2; ++n) _Pragma("unroll") for (int k = 0; k < 2; ++k) \
        acc[ai][bj][m][n] = __builtin_amdgcn_mfma_f32_16x16x32_bf16(Bt[n][k], At[m][k], acc[ai][bj][m][n], 0, 0, 0); __builtin_amdgcn_s_setprio(0); } while (0)
#define PG8_WAIT_V(n) asm volatile("s_waitcnt vmcnt(" #n ")" ::: "memory")
#define PG8_WAIT_L(n) asm volatile("s_waitcnt lgkmcnt(" #n ")" ::: "memory")
#define PG8_BAR __builtin_amdgcn_s_barrier()
#define PG8_SCHED __builtin_amdgcn_sched_barrier(0)
    Unit cur, nxt; int ui = 0;
    if (!S.next(0, cur)) return;
    f32x4 acc[2][2][4][2];
#pragma unroll
    for (int a = 0; a < 2; ++a)
#pragma unroll
        for (int b = 0; b < 2; ++b)
#pragma unroll
            for (int m = 0; m < 4; ++m)
#pragma unroll
                for (int n = 0; n < 2; ++n) acc[a][b][m][n] = (f32x4){0.f, 0.f, 0.f, 0.f};
    bf16x8 At[4][2], B0[2][2], B1[2][2];
    const char* cA = (const char*)g.A + (size_t)cur.pm * tstep; const char* cB = (const char*)g.Bt + (size_t)cur.pn * tstep;
    PG8_STAGE(PG8_SB(0, 0), cB, voffB); PG8_STAGE(PG8_SB(0, 1), cB + hstep, voffB); PG8_STAGE(PG8_SA(0, 0), cA, voffA); PG8_STAGE(PG8_SA(0, 1), cA + hstep, voffA);
    if (wr == 1) PG8_BAR;
    PG8_WAIT_V(2); PG8_BAR;
    PG8_STAGE(PG8_SB(1, 0), cB + kstep, voffB); PG8_STAGE(PG8_SA(1, 0), cA + kstep, voffA); PG8_STAGE(PG8_SB(1, 1), cB + hstep + kstep, voffB);
    PG8_WAIT_V(6); PG8_BAR;
    for (;;) {
        const bool has_next = S.next(ui + 1, nxt);
        const char* nA = has_next ? (const char*)g.A + (size_t)nxt.pm * tstep : cA; const char* nB = has_next ? (const char*)g.Bt + (size_t)nxt.pn * tstep : cB;
        for (int t = 0; t < nt; t += 2) {
            const bool last = (t == nt - 2);
            const char* a1 = cA + (size_t)(t + 1) * kstep;
            const char* a2 = last ? nA : cA + (size_t)(t + 2) * kstep; const char* b2 = last ? nB : cB + (size_t)(t + 2) * kstep;
            const char* a3 = a2 + kstep; const char* b3 = b2 + kstep;
            PG8_LDB(B0, 0, 0); PG8_LDB(B1, 0, 1); PG8_SCHED; PG8_LDA(At, 0, 0); PG8_STAGE(PG8_SA(1, 1), a1 + hstep, voffA);
            PG8_WAIT_V(8); PG8_WAIT_L(0); PG8_BAR; PG8_MMA(0, 0, At, B0); PG8_MMA(0, 1, At, B1); PG8_BAR; PG8_SCHED;
            PG8_LDA(At, 0, 1); PG8_STAGE(PG8_SB(0, 0), b2, voffB); PG8_STAGE(PG8_SB(0, 1), b2 + hstep, voffB); PG8_STAGE(PG8_SA(0, 0), a2, voffA);
            PG8_WAIT_V(8); PG8_WAIT_L(0); PG8_BAR; PG8_MMA(1, 0, At, B0); PG8_MMA(1, 1, At, B1); PG8_BAR; PG8_SCHED;
            PG8_LDB(B0, 1, 0); PG8_LDB(B1, 1, 1); PG8_SCHED; PG8_LDA(At, 1, 0); PG8_STAGE(PG8_SA(0, 1), a2 + hstep, voffA);
            PG8_WAIT_V(8); PG8_WAIT_L(0); PG8_BAR; PG8_MMA(0, 0, At, B0); PG8_MMA(0, 1, At, B1); PG8_BAR; PG8_SCHED;
            PG8_LDA(At, 1, 1); PG8_STAGE(PG8_SB(1, 0), b3, voffB); PG8_STAGE(PG8_SB(1, 1), b3 + hstep, voffB); PG8_STAGE(PG8_SA(1, 0), a3, voffA);
            PG8_WAIT_V(8); PG8_WAIT_L(0); PG8_BAR; PG8_MMA(1, 0, At, B0); PG8_MMA(1, 1, At, B1); PG8_BAR; PG8_SCHED;
        }
        if constexpr (ALIGN_EPI) { if (wr == 0) PG8_BAR; }
        E(acc, cur, wr, wc, fr, fq);
        if (!has_next) break;
#pragma unroll
        for (int a = 0; a < 2; ++a)
#pragma unroll
            for (int b = 0; b < 2; ++b)
#pragma unroll
                for (int m = 0; m < 4; ++m)
#pragma unroll
                    for (int n = 0; n < 2; ++n) acc[a][b][m][n] = (f32x4){0.f, 0.f, 0.f, 0.f};
        cur = nxt; cA = nA; cB = nB; ++ui;
        if constexpr (ALIGN_EPI) { if (wr == 1) PG8_BAR; }
    }
    PG8_WAIT_V(0);
    if constexpr (!ALIGN_EPI) { if (wr == 0) PG8_BAR; }
    PG8_BAR;
#undef PG8_SA
#undef PG8_SB
#undef PG8_STAGE
#undef PG8_LDA
#undef PG8_LDB
#undef PG8_MMA
#undef PG8_WAIT_V
#undef PG8_WAIT_L
#undef PG8_BAR
#undef PG8_SCHED
}
}

constexpr int LAST_PM = MPR / 256;

struct EpiSwiglu {
    static constexpr bool PERM = true;
    bf16_t* H; const float* rowss;
    __device__ __forceinline__ void operator()(const f32x4 (&acc)[2][2][4][2], const pg8::Unit& u, int wr, int wc, int fr, int fq) const {
        const int row0 = u.pm * 256 + wr * 64 + fr, col0 = u.pn * 128 + wc * 32 + 8 * fq;
        const int nai = (u.pm == LAST_PM) ? 1 : 2;
#pragma unroll
        for (int ai = 0; ai < 2; ++ai) { if (ai < nai) {
#pragma unroll
            for (int m = 0; m < 4; ++m) {
                const int r = row0 + ai * 128 + m * 16;
                const float rs = __builtin_amdgcn_rsqf(rowss[r] * (1.0f / D) + EPS);
                float h[8];
#pragma unroll
                for (int n = 0; n < 2; ++n)
#pragma unroll
                    for (int j = 0; j < 4; ++j) { const float gv = acc[ai][0][m][n][j] * rs, uv = acc[ai][1][m][n][j] * rs; h[n * 4 + j] = siluf_(gv) * uv; }
                u32x4 w; w.x = cvt_pk_bf16(h[0], h[1]); w.y = cvt_pk_bf16(h[2], h[3]); w.z = cvt_pk_bf16(h[4], h[5]); w.w = cvt_pk_bf16(h[6], h[7]);
                *(u32x4*)(H + (size_t)r * FF + col0) = w;
            }
        } }
    }
};

struct EpiResid {
    static constexpr bool PERM = false;
    const float* baseP; const float* baseS; float* out; bf16_t* HB; float* rowss_next; float scale;
    __device__ __forceinline__ void operator()(const f32x4 (&acc)[2][2][4][2], const pg8::Unit& u, int wr, int wc, int fr, int fq) const {
        const int row0 = u.pm * 256 + wr * 64 + fr, col0 = u.pn * 256 + wc * 32 + 4 * fq;
        const int nai = (u.pm == LAST_PM) ? 1 : 2;
#pragma unroll
        for (int ai = 0; ai < 2; ++ai) { if (ai < nai) {
#pragma unroll
            for (int m = 0; m < 4; ++m) {
                const int r = row0 + ai * 128 + m * 16;
                const float* b = (r < MPR) ? baseP + (size_t)r * D : baseS + (size_t)(r - MPR) * D;
                float ss = 0.f;
#pragma unroll
                for (int bj = 0; bj < 2; ++bj)
#pragma unroll
                    for (int n = 0; n < 2; ++n) {
                        const int c = col0 + bj * 128 + n * 16;
                        const f32x4 bs = *(const f32x4*)(b + c);
                        const f32x4 a = acc[ai][bj][m][n];
                        const f32x4 o = bs + a * scale;
                        *(f32x4*)(out + (size_t)r * D + c) = o;
                        ss += (o[0] * o[0] + o[1] * o[1]) + (o[2] * o[2] + o[3] * o[3]);
                        u32x2 w; w.x = cvt_pk_bf16(o[0], o[1]); w.y = cvt_pk_bf16(o[2], o[3]);
                        *(u32x2*)(HB + (size_t)r * D + c) = w;
                    }
                ss += __shfl_xor(ss, 16); ss += __shfl_xor(ss, 32);
                if (fq == 0) atomicAdd(rowss_next + r, ss);
            }
        } }
    }
};

struct EpiMixIn {
    static constexpr bool PERM = true;
    bf16_t* UG; const float* rowss; const float* bin; float* vsum; float* ncp; int l;
    __device__ __forceinline__ void operator()(const f32x4 (&acc)[2][2][4][2], const pg8::Unit& u, int wr, int wc, int fr, int fq) const {
        const int row0 = u.pm * 256 + wr * 64 + fr;
        const int nai = (u.pm == LAST_PM) ? 1 : 2;
        const int type = u.pn >> 3;
        bf16_t* const GV = UG + (size_t)MPAD * D; bf16_t* const XG = GV + (size_t)MPAD * D; bf16_t* const BS = XG + (size_t)MPAD * D;
        float* const vsq = vsum + MPAD; float* const ncs = ncp + (O_NCS - O_NCP) + (size_t)l * (NS - NB) * 2 * D;
        if (type < 3) {
            const int col0 = (u.pn & 7) * 128 + wc * 32 + 8 * fq;
            const int o0 = type == 0 ? 0 : (type == 1 ? 3072 : 2048), o1 = type == 0 ? 5120 : (type == 1 ? 4096 : 6144);
            bf16_t* O = type == 0 ? UG : (type == 1 ? XG : BS);
            const f32x4 b00 = *(const f32x4*)(bin + o0 + col0), b01 = *(const f32x4*)(bin + o0 + col0 + 4);
            const f32x4 b10 = *(const f32x4*)(bin + o1 + col0), b11 = *(const f32x4*)(bin + o1 + col0 + 4);
#pragma unroll
            for (int ai = 0; ai < 2; ++ai) { if (ai < nai) {
#pragma unroll
                for (int m = 0; m < 4; ++m) {
                    const int r = row0 + ai * 128 + m * 16;
                    const float rs = __builtin_amdgcn_rsqf(rowss[r] * (1.0f / D) + EPS);
                    f32x4 p0 = acc[ai][0][m][0] * rs + b00, p1 = acc[ai][0][m][1] * rs + b01;
                    f32x4 q0 = acc[ai][1][m][0] * rs + b10, q1 = acc[ai][1][m][1] * rs + b11;
                    f32x4 r0, r1;
                    if (type == 0) { p0 = gelu4(p0); p1 = gelu4(p1);
#pragma unroll
                        for (int j = 0; j < 4; ++j) { r0[j] = p0[j] * sigmoidf_(q0[j]); r1[j] = p1[j] * sigmoidf_(q1[j]); } }
                    else if (type == 1) { r0 = p0 * q0; r1 = p1 * q1;
                        if (r < MPR) { const int t = r & (SEQ - 1); if (t >= SEQ - 2) { float* o = ncp + ((size_t)((r >> 11) * 2 + (t - (SEQ - 2)))) * D + col0; *(f32x4*)o = r0; *(f32x4*)(o + 4) = r1; } }
                        else { float* o = ncs + ((size_t)((r - MPR) * 2 + 1)) * D + col0; *(f32x4*)o = r0; *(f32x4*)(o + 4) = r1; } }
                    else {
#pragma unroll
                        for (int j = 0; j < 4; ++j) { r0[j] = p0[j] * sigmoidf_(q0[j]); r1[j] = p1[j] * sigmoidf_(q1[j]); } }
                    u32x4 w; w.x = cvt_pk_bf16(r0[0], r0[1]); w.y = cvt_pk_bf16(r0[2], r0[3]); w.z = cvt_pk_bf16(r1[0], r1[1]); w.w = cvt_pk_bf16(r1[2], r1[3]);
                    *(u32x4*)(O + (size_t)r * D + col0) = w;
                }
            } }
        } else {
            const int col0 = (u.pn - 24) * 256 + wc * 32 + 8 * fq;
            f32x4 bv[2][2];
#pragma unroll
            for (int bj = 0; bj < 2; ++bj)
#pragma unroll
                for (int n = 0; n < 2; ++n) bv[bj][n] = *(const f32x4*)(bin + 1024 + col0 + bj * 128 + 4 * n);
#pragma unroll
            for (int ai = 0; ai < 2; ++ai) { if (ai < nai) {
#pragma unroll
                for (int m = 0; m < 4; ++m) {
                    const int r = row0 + ai * 128 + m * 16;
                    const float rs = __builtin_amdgcn_rsqf(rowss[r] * (1.0f / D) + EPS);
                    float s1 = 0.f, s2 = 0.f;
#pragma unroll
                    for (int bj = 0; bj < 2; ++bj) {
                        f32x4 v0 = gelu4(acc[ai][bj][m][0] * rs + bv[bj][0]), v1 = gelu4(acc[ai][bj][m][1] * rs + bv[bj][1]);
                        s1 += (v0[0] + v0[1]) + (v0[2] + v0[3]) + (v1[0] + v1[1]) + (v1[2] + v1[3]);
                        s2 += (v0[0] * v0[0] + v0[1] * v0[1]) + (v0[2] * v0[2] + v0[3] * v0[3]) + (v1[0] * v1[0] + v1[1] * v1[1]) + (v1[2] * v1[2] + v1[3] * v1[3]);
                        u32x4 w; w.x = cvt_pk_bf16(v0[0], v0[1]); w.y = cvt_pk_bf16(v0[2], v0[3]); w.z = cvt_pk_bf16(v1[0], v1[1]); w.w = cvt_pk_bf16(v1[2], v1[3]);
                        *(u32x4*)(GV + (size_t)r * D + col0 + bj * 128) = w;
                    }
                    s1 += __shfl_xor(s1, 16); s1 += __shfl_xor(s1, 32); s2 += __shfl_xor(s2, 16); s2 += __shfl_xor(s2, 32);
                    if (fq == 0) { atomicAdd(vsum + r, s1); atomicAdd(vsq + r, s2); }
                }
            } }
        }
    }
};


#define XB_TMO      128
#define XB_XCNT(j)  (256  + 64 * (j))
#define XB_XSUB(j)  (1280 + 64 * (j))
#define XB_XGEN(j)  (2304 + 64 * (j))
#define XB_TOP      3328
#define XB_TOPGEN   3392
#define XCD_BAR_WORDS 3456
#define XB_SPIN_CAP (1u << 18)
__device__ __forceinline__ unsigned xb_ld(unsigned* p)              { return __hip_atomic_load(p, __ATOMIC_RELAXED, __HIP_MEMORY_SCOPE_AGENT); }
__device__ __forceinline__ unsigned xb_add(unsigned* p, unsigned v) { return __hip_atomic_fetch_add(p, v, __ATOMIC_RELAXED, __HIP_MEMORY_SCOPE_AGENT); }
__device__ __forceinline__ unsigned xb_xcc_id() { return (unsigned)__builtin_amdgcn_s_getreg((3 << 11) | 20) & 0xFu; }
#define XB_SPIN(cond, bar) do { unsigned _sp = 0; while (cond) { __builtin_amdgcn_s_sleep(1); \
    if ((++_sp & 255u) == 0u) { if (xb_ld(&(bar)[XB_TMO])) break; if (_sp > XB_SPIN_CAP) { atomicAdd(&(bar)[XB_TMO], 1u); break; } } } } while (0)
struct XcdBarrier { unsigned* bar; unsigned x; volatile LAS unsigned* st; };
__device__ __forceinline__ XcdBarrier xcd_barrier_post(unsigned* bar, volatile LAS unsigned* st) {
    XcdBarrier b; b.bar = bar; b.x = xb_xcc_id(); b.st = st;
    if (threadIdx.x == 0) (void)xb_add(&bar[XB_XCNT(b.x)], 1u);
    return b;
}
__device__ __forceinline__ void xcd_barrier_complete(unsigned* bar, unsigned x, unsigned& nloc, unsigned& nx) {
    const unsigned G = gridDim.x * gridDim.y * gridDim.z;
    unsigned sum, cnt, mine, sp = 0u;
    for (;;) {
        sum = 0u; cnt = 0u; mine = 0u;
#pragma unroll
        for (unsigned j = 0; j < 16; ++j) { const unsigned c = xb_ld(&bar[XB_XCNT(j)]); sum += c; cnt += (c > 0u) ? 1u : 0u; mine = (j == x) ? c : mine; }
        if (sum == G) break;
        __builtin_amdgcn_s_sleep(1);
        if ((++sp & 255u) == 0u) { if (xb_ld(&bar[XB_TMO])) break; if (sp > XB_SPIN_CAP) { atomicAdd(&bar[XB_TMO], 1u); break; } }
    }
    nloc = mine > 0u ? mine : 1u; nx = cnt > 0u ? cnt : 1u;
}
__device__ __forceinline__ void xcd_barrier(const XcdBarrier& b) {
    asm volatile("s_waitcnt vmcnt(0)" ::: "memory");
    __syncthreads();
    if (threadIdx.x == 0) {
        unsigned* bar = b.bar;
        __builtin_amdgcn_s_waitcnt(0);
        unsigned nloc = b.st[0], nx = b.st[1];
        if (nloc == 0u) { xcd_barrier_complete(bar, b.x, nloc, nx); b.st[0] = nloc; b.st[1] = nx; }
        const unsigned old = xb_add(&bar[XB_XSUB(b.x)], 1u);
        const unsigned gen = old / nloc;
        if (old + 1u == (gen + 1u) * nloc) {
            __builtin_amdgcn_fence(__ATOMIC_RELEASE, "agent");
            asm volatile("s_waitcnt vmcnt(0)" ::: "memory");
            const unsigned og = xb_add(&bar[XB_TOP], 1u);
            const unsigned tg = og / nx;
            if (og + 1u == (tg + 1u) * nx) xb_add(&bar[XB_TOPGEN], 1u);
            else XB_SPIN(xb_ld(&bar[XB_TOPGEN]) == tg, bar);
            __builtin_amdgcn_fence(__ATOMIC_ACQUIRE, "agent");
            xb_add(&bar[XB_XGEN(b.x)], 1u);
            asm volatile("s_waitcnt vmcnt(0)" ::: "memory");
        } else {
            XB_SPIN(xb_ld(&bar[XB_XGEN(b.x)]) == gen, bar);
            __builtin_amdgcn_fence(__ATOMIC_ACQUIRE, "agent");
            asm volatile("s_waitcnt vmcnt(0)" ::: "memory");
        }
    }
    __syncthreads();
}

constexpr int RED_OFF = 131072, MISC_OFF = RED_OFF + 8192;
template <int NKS  , int CH>
__device__ __forceinline__ void skinny_resid(LAS unsigned char* lds, const bf16_t* A, const bf16_t* Bt, int item, const EpiResid& E) {
    constexpr int K = NKS * 128;
    int tid_ = threadIdx.x; asm volatile("" : "+v"(tid_));
    const int tid = tid_, lane = tid & 63, w = __builtin_amdgcn_readfirstlane(tid >> 6), fr = lane & 15, fq = lane >> 4;
    const int cgn = item >> 2, rh = item & 3, rsub = w & 1, ksp = w >> 1;
    const int rloc = 32 * rh + 16 * rsub + fr;
    const bf16_t* ap = A + (size_t)(MPR + rloc) * K + ksp * (NKS * 32) + 8 * fq;
    const bf16_t* bp = Bt + (size_t)(16 * cgn + fr) * K + ksp * (NKS * 32) + 8 * fq;
    f32x4 acc = (f32x4){0.f, 0.f, 0.f, 0.f};
#pragma unroll 1
    for (int c = 0; c < NKS / CH; ++c) {
        bf16x8 av[CH], bv[CH];
#pragma unroll
        for (int j = 0; j < CH; ++j) { av[j] = *(const bf16x8*)(ap + 32 * (c * CH + j)); bv[j] = *(const bf16x8*)(bp + 32 * (c * CH + j)); }
#pragma unroll
        for (int j = 0; j < CH; ++j) acc = __builtin_amdgcn_mfma_f32_16x16x32_bf16(bv[j], av[j], acc, 0, 0, 0);
    }
    LAS f32x4* red = (LAS f32x4*)(lds + RED_OFF);
    red[w * 64 + lane] = acc;
    __syncthreads();
    if (ksp == 0) {
        acc = acc + red[(w + 2) * 64 + lane] + red[(w + 4) * 64 + lane] + red[(w + 6) * 64 + lane];
        const int r = MPR + rloc, c = 16 * cgn + 4 * fq;
        const f32x4 bs = *(const f32x4*)(E.baseS + (size_t)rloc * D + c);
        const f32x4 o = bs + acc * E.scale;
        *(f32x4*)(E.out + (size_t)r * D + c) = o;
        float ss = (o[0] * o[0] + o[1] * o[1]) + (o[2] * o[2] + o[3] * o[3]);
        u32x2 wv; wv.x = cvt_pk_bf16(o[0], o[1]); wv.y = cvt_pk_bf16(o[2], o[3]);
        *(u32x2*)(E.HB + (size_t)r * D + c) = wv;
        ss += __shfl_xor(ss, 16); ss += __shfl_xor(ss, 32);
        if (fq == 0) atomicAdd(E.rowss_next + r, ss);
    }
    __syncthreads();
}

struct Args { const float* in[21]; float* out; unsigned char* ws; };
typedef const __attribute__((address_space(4))) Args* KArgs;
__device__ __forceinline__ KArgs kargs() { KArgs p = (KArgs)__builtin_amdgcn_kernarg_segment_ptr(); asm volatile("" : "+s"(p)); return p; }
enum { I_XP = 0, I_XS, I_STATE, I_F1N, I_F1G, I_F1U, I_F1D, I_MIXN, I_WIN, I_BIN, I_VG, I_VB, I_WSP, I_BSP, I_CW, I_WO, I_F2N, I_F2G, I_F2U, I_F2D, I_FN };

__device__ __forceinline__ void transpose_item(const float* W, int N, int srccol0, const float* gain, bf16_t* WT, int K, int destrow0, int k0, int lane) {
    const int nq = lane & 15, ko = lane >> 4;
#pragma unroll
    for (int h = 0; h < 2; ++h) {
        const int kb = k0 + 32 * h + 8 * ko;
        f32x4 v[8];
#pragma unroll
        for (int j = 0; j < 8; ++j) v[j] = *(const f32x4*)(W + (size_t)(kb + j) * N + srccol0 + 4 * nq);
        if (gain) { const f32x4 g0 = *(const f32x4*)(gain + kb), g1 = *(const f32x4*)(gain + kb + 4);
#pragma unroll
            for (int j = 0; j < 4; ++j) { v[j] = v[j] * g0[j]; v[4 + j] = v[4 + j] * g1[j]; } }
#pragma unroll
        for (int i = 0; i < 4; ++i) { u32x4 o; o.x = cvt_pk_bf16(v[0][i], v[1][i]); o.y = cvt_pk_bf16(v[2][i], v[3][i]); o.z = cvt_pk_bf16(v[4][i], v[5][i]); o.w = cvt_pk_bf16(v[6][i], v[7][i]);
            *(u32x4*)(WT + (size_t)(destrow0 + 4 * nq + i) * K + kb) = o; }
    }
}
__device__ __forceinline__ int win_srccol(int nprime) {
    const int pn = nprime >> 8, w = nprime & 255, half = w >> 7, cw = w & 127;
    if (pn < 8) return (half ? 5120 : 0) + 128 * pn + cw;
    if (pn < 16) return (half ? 4096 : 3072) + 128 * (pn - 8) + cw;
    if (pn < 24) return (half ? 6144 : 2048) + 128 * (pn - 16) + cw;
    return 1024 + 256 * (pn - 24) + w;
}
constexpr int IT_W1 = 16 * 88, IT_W2 = 44 * 16, IT_WIN = 16 * 112, IT_WO = 16 * 16, IT_LAYER = 2 * IT_W1 + 2 * IT_W2 + IT_WIN + IT_WO;

__device__ __forceinline__ void prologue(KArgs a, LAS unsigned char* lds) {
    const int tid = threadIdx.x, lane = tid & 63, wave = tid >> 6;
    const int gw = blockIdx.x * 8 + wave, NGW = gridDim.x * 8;
    float* stat = (float*)(a->ws + WS_STAT);
    for (size_t i = (size_t)blockIdx.x * 512 + tid; i < (size_t)10 * MPAD; i += (size_t)gridDim.x * 512) stat[MPAD + i] = 0.f;
    if (blockIdx.x == 0 && tid < MPAD - M) stat[M + tid] = 0.f;
    bf16_t* HB = (bf16_t*)(a->ws + WS_HB);
    for (int r = gw; r < M; r += NGW) {
        const float* xr = (r < MPR) ? a->in[I_XP] + (size_t)r * D : a->in[I_XS] + (size_t)(r - MPR) * D;
        const f32x4* x4 = (const f32x4*)xr + lane;
        unsigned long long* o8 = (unsigned long long*)(HB + (size_t)r * D) + lane;
        float s = 0.f;
#pragma unroll
        for (int j = 0; j < 4; ++j) { const f32x4 v = x4[64 * j]; s += (v[0] * v[0] + v[1] * v[1]) + (v[2] * v[2] + v[3] * v[3]);
            o8[64 * j] = (unsigned long long)cvt_pk_bf16(v[0], v[1]) | ((unsigned long long)cvt_pk_bf16(v[2], v[3]) << 32); }
        s = wave_sum(s);
        if (lane == 0) stat[r] = s;
    }
    for (int i = blockIdx.x * 512 + tid; i < DEPTH * NS * (D / 4); i += gridDim.x * 512) {
        const int ls = i / (D / 4), c4 = i % (D / 4);
        *((f32x4*)(a->out + O_NCS + (size_t)(ls * 2) * D) + c4) = *((const f32x4*)(a->in[I_STATE] + (size_t)(ls * 2 + 1) * D) + c4);
    }
    for (int it = gw; it < DEPTH * IT_LAYER; it += NGW) {
        const int l = it / IT_LAYER; int r = it % IT_LAYER;
        bf16_t* WL = (bf16_t*)(a->ws + WS_W) + (size_t)l * LAYER_W_ELEMS;
        if (r < 2 * IT_W1) {
            const int which = r / IT_W1; r %= IT_W1; const int kb = r / 88, nb = r % 88, np = 64 * nb, pn = np >> 8, w = np & 255, half = w >> 7, cw = w & 127;
            const float* src = a->in[which ? (half ? I_F2U : I_F2G) : (half ? I_F1U : I_F1G)] + (size_t)l * D * FF;
            transpose_item(src, FF, 128 * pn + cw, a->in[which ? I_F2N : I_F1N] + l * D, WL + (which ? OW6 : OW1), D, np, 64 * kb, lane);
            continue; }
        r -= 2 * IT_W1;
        if (r < 2 * IT_W2) {
            const int which = r / IT_W2; r %= IT_W2; const int kb = r / 16, nb = r % 16;
            transpose_item(a->in[which ? I_F2D : I_F1D] + (size_t)l * FF * D, D, 64 * nb, nullptr, WL + (which ? OW7 : OW2), FF, 64 * nb, 64 * kb, lane);
            continue; }
        r -= 2 * IT_W2;
        if (r < IT_WIN) { const int kb = r / 112, nb = r % 112;
            transpose_item(a->in[I_WIN] + (size_t)l * D * NIN, NIN, win_srccol(64 * nb), a->in[I_MIXN] + l * D, WL + OWIN, D, 64 * nb, 64 * kb, lane);
            continue; }
        r -= IT_WIN;
        { const int kb = r / 16, nb = r % 16;
            transpose_item(a->in[I_WO] + (size_t)l * D * D, D, 64 * nb, nullptr, WL + OWO, D, 64 * nb, 64 * kb, lane); }
    }
}

constexpr int TROW = 272;
constexpr int T_OFF = 0, W_OFF = 256 * TROW, ST_OFF = W_OFF + 128 * TROW;
__device__ __forceinline__ void mix_prompt_item(KArgs a, LAS unsigned char* lds, int l, int chunk, int g) {
    int tid_ = threadIdx.x; asm volatile("" : "+v"(tid_));
    const int tid = tid_, lane = tid & 63, wave = __builtin_amdgcn_readfirstlane(tid >> 6), fr = lane & 15, fq = lane >> 4;
    float* stat = (float*)(a->ws + WS_STAT);
    const float* vsum = stat + (size_t)(7 + 2 * l) * MPAD; const float* vsq = vsum + MPAD;
    bf16_t* UG = (bf16_t*)(a->ws + WS_R); const bf16_t* GV = UG + (size_t)MPAD * D; const bf16_t* XG = GV + (size_t)MPAD * D; const bf16_t* BS = XG + (size_t)MPAD * D;
    const int row0 = chunk * 128;
    LAS float* st = (LAS float*)(lds + ST_OFF);
    if (tid < 128) { const int r = row0 + tid; const float mean = vsum[r] * (1.0f / D); const float var = fmaxf(vsq[r] * (1.0f / D) - mean * mean, 0.f);
        st[2 * tid] = mean; st[2 * tid + 1] = __builtin_amdgcn_rsqf(var + EPS); }
    {
        const int t = tid >> 2, s0 = (tid & 3) * 32; const float* wp = a->in[I_WSP] + ((size_t)(l * 4 + g) * 128 + t) * 128 + s0;
#pragma unroll
        for (int q = 0; q < 4; ++q) { const f32x4 w0 = *(const f32x4*)(wp + 8 * q), w1 = *(const f32x4*)(wp + 8 * q + 4); float e[8] = {w0[0], w0[1], w0[2], w0[3], w1[0], w1[1], w1[2], w1[3]};
#pragma unroll
            for (int j = 0; j < 8; ++j) e[j] = (s0 + 8 * q + j <= t) ? e[j] : 0.f;
            u32x4 o; o.x = cvt_pk_bf16(e[0], e[1]); o.y = cvt_pk_bf16(e[2], e[3]); o.z = cvt_pk_bf16(e[4], e[5]); o.w = cvt_pk_bf16(e[6], e[7]);
            *(LAS u32x4*)(lds + W_OFF + t * TROW + (s0 + 8 * q) * 2) = o; }
    }
    __syncthreads();
    {
        const float* vg = a->in[I_VG] + l * D + 256 * g; const float* vb = a->in[I_VB] + l * D + 256 * g;
#pragma unroll 2
        for (int i = 0; i < 8; ++i) { const int idx = i * 512 + tid, s = idx & 127, d = (idx >> 7) * 8;
            const u32x4 x = *(const u32x4*)(GV + (size_t)(row0 + s) * D + 256 * g + d);
            const float mean = st[2 * s], rstd = st[2 * s + 1];
            const f32x4 g0 = *(const f32x4*)(vg + d), g1 = *(const f32x4*)(vg + d + 4), c0 = *(const f32x4*)(vb + d), c1 = *(const f32x4*)(vb + d + 4);
            float e[8] = {bf_lo(x.x), bf_hi(x.x), bf_lo(x.y), bf_hi(x.y), bf_lo(x.z), bf_hi(x.z), bf_lo(x.w), bf_hi(x.w)};
            const float gg[8] = {g0[0], g0[1], g0[2], g0[3], g1[0], g1[1], g1[2], g1[3]}; const float cc[8] = {c0[0], c0[1], c0[2], c0[3], c1[0], c1[1], c1[2], c1[3]};
#pragma unroll
            for (int j = 0; j < 8; ++j) { const float v = (e[j] - mean) * rstd * gg[j] + cc[j]; *(LAS bf16_t*)(lds + T_OFF + (d + j) * TROW + s * 2) = (bf16_t)(cvt_pk_bf16(v, 0.f) & 0xffffu); }
        }
    }
    __syncthreads();
    f32x4 acc[16];
#pragma unroll
    for (int n = 0; n < 16; ++n) acc[n] = (f32x4){0.f, 0.f, 0.f, 0.f};
    const int kmax = (16 * wave + 15) >> 5;
    for (int ks = 0; ks <= kmax; ++ks) {
        const bf16x8 af = *(const LAS bf16x8*)(lds + W_OFF + (16 * wave + fr) * TROW + (32 * ks + 8 * fq) * 2);
#pragma unroll
        for (int n = 0; n < 16; ++n) { const bf16x8 bfr = *(const LAS bf16x8*)(lds + T_OFF + (16 * n + fr) * TROW + (32 * ks + 8 * fq) * 2);
            acc[n] = __builtin_amdgcn_mfma_f32_16x16x32_bf16(bfr, af, acc[n], 0, 0, 0); }
    }
    {
        const int t = 16 * wave + fr, r = row0 + t, tseq = r & (SEQ - 1);
        const float bsp = a->in[I_BSP][(l * 4 + g) * 128 + t];
        const float* cw = a->in[I_CW] + (size_t)l * 3 * D;
#pragma unroll
        for (int n = 0; n < 16; ++n) { if ((n & 1) == 0) asm volatile("" ::: "memory");
            const int d = 256 * g + 16 * n + 4 * fq; const size_t off = (size_t)r * D + d;
            const u32x2 ug = *(const u32x2*)(UG + off), bs = *(const u32x2*)(BS + off), x0 = *(const u32x2*)(XG + off);
            u32x2 x1 = (u32x2){0u, 0u}, x2 = (u32x2){0u, 0u};
            if (tseq >= 1) x1 = *(const u32x2*)(XG + off - D);
            if (tseq >= 2) x2 = *(const u32x2*)(XG + off - 2 * D);
            const f32x4 w0 = *(const f32x4*)(cw + d), w1 = *(const f32x4*)(cw + D + d), w2 = *(const f32x4*)(cw + 2 * D + d);
            const float ugf[4] = {bf_lo(ug.x), bf_hi(ug.x), bf_lo(ug.y), bf_hi(ug.y)}, bsf[4] = {bf_lo(bs.x), bf_hi(bs.x), bf_lo(bs.y), bf_hi(bs.y)};
            const float x0f[4] = {bf_lo(x0.x), bf_hi(x0.x), bf_lo(x0.y), bf_hi(x0.y)}, x1f[4] = {bf_lo(x1.x), bf_hi(x1.x), bf_lo(x1.y), bf_hi(x1.y)}, x2f[4] = {bf_lo(x2.x), bf_hi(x2.x), bf_lo(x2.y), bf_hi(x2.y)};
            float mo[4];
#pragma unroll
            for (int j = 0; j < 4; ++j) mo[j] = ugf[j] * (acc[n][j] + bsp) + bsf[j] * (w0[j] * x2f[j] + w1[j] * x1f[j] + w2[j] * x0f[j]);
            u32x2 o; o.x = cvt_pk_bf16(mo[0], mo[1]); o.y = cvt_pk_bf16(mo[2], mo[3]);
            *(u32x2*)(UG + off) = o; }
    }
    __syncthreads();
}
__device__ __forceinline__ void mix_sample_item(KArgs a, int l, int g) {
    const int tid = threadIdx.x;
    float* stat = (float*)(a->ws + WS_STAT);
    const float* vsum = stat + (size_t)(7 + 2 * l) * MPAD; const float* vsq = vsum + MPAD;
    bf16_t* UG = (bf16_t*)(a->ws + WS_R); const bf16_t* GV = UG + (size_t)MPAD * D; const bf16_t* XG = GV + (size_t)MPAD * D; const bf16_t* BS = XG + (size_t)MPAD * D;
    const float w00 = a->in[I_WSP][(size_t)(l * 4 + g) * 128 * 128], b0 = a->in[I_BSP][(l * 4 + g) * 128];
    const float* cw = a->in[I_CW] + (size_t)l * 3 * D;
    for (int i = 0; i < 8; ++i) { const int idx = i * 512 + tid, s = idx >> 5, d = 256 * g + (idx & 31) * 8; const int r = MPR + s; const size_t off = (size_t)r * D + d;
        const float mean = vsum[r] * (1.0f / D); const float var = fmaxf(vsq[r] * (1.0f / D) - mean * mean, 0.f); const float rstd = __builtin_amdgcn_rsqf(var + EPS);
        const u32x4 gv = *(const u32x4*)(GV + off), ug = *(const u32x4*)(UG + off), bs = *(const u32x4*)(BS + off), xg = *(const u32x4*)(XG + off);
        const float gvf[8] = {bf_lo(gv.x), bf_hi(gv.x), bf_lo(gv.y), bf_hi(gv.y), bf_lo(gv.z), bf_hi(gv.z), bf_lo(gv.w), bf_hi(gv.w)};
        const float ugf[8] = {bf_lo(ug.x), bf_hi(ug.x), bf_lo(ug.y), bf_hi(ug.y), bf_lo(ug.z), bf_hi(ug.z), bf_lo(ug.w), bf_hi(ug.w)};
        const float bsf[8] = {bf_lo(bs.x), bf_hi(bs.x), bf_lo(bs.y), bf_hi(bs.y), bf_lo(bs.z), bf_hi(bs.z), bf_lo(bs.w), bf_hi(bs.w)};
        const float xgf[8] = {bf_lo(xg.x), bf_hi(xg.x), bf_lo(xg.y), bf_hi(xg.y), bf_lo(xg.z), bf_hi(xg.z), bf_lo(xg.w), bf_hi(xg.w)};
        const float* st0 = a->in[I_STATE] + ((size_t)(l * NS + s) * 2) * D + d; const float* st1 = st0 + D;
        float* vo = a->out + O_VS + ((size_t)(l * NS + s)) * D + d;
        float mo[8];
#pragma unroll
        for (int j = 0; j < 8; ++j) { const float vp = (gvf[j] - mean) * rstd * a->in[I_VG][l * D + d + j] + a->in[I_VB][l * D + d + j]; vo[j] = vp;
            const float conv = cw[d + j] * st0[j] + cw[D + d + j] * st1[j] + cw[2 * D + d + j] * xgf[j];
            mo[j] = ugf[j] * (w00 * vp + b0) + bsf[j] * conv; }
        u32x4 o; o.x = cvt_pk_bf16(mo[0], mo[1]); o.y = cvt_pk_bf16(mo[2], mo[3]); o.z = cvt_pk_bf16(mo[4], mo[5]); o.w = cvt_pk_bf16(mo[6], mo[7]);
        *(u32x4*)(UG + off) = o; }
}

__global__ void __launch_bounds__(512, 2) fwd_megakernel(Args a_unused) {
    extern __shared__ __attribute__((aligned(16))) unsigned char lds_raw[];
    LAS unsigned char* lds = (LAS unsigned char*)lds_raw;
    cg::grid_group grid = cg::this_grid();
    const int G = gridDim.x, bid = blockIdx.x;

    if (threadIdx.x < 8) ((LAS unsigned*)(lds + MISC_OFF))[threadIdx.x] = 0u;
    __syncthreads();
    XcdBarrier bar;
    { KArgs p = kargs(); if (p->ws == nullptr) grid.sync();
      bar = xcd_barrier_post((unsigned*)(p->ws + WS_BAR), (volatile LAS unsigned*)(lds + MISC_OFF)); }
#define GRID_SYNC() xcd_barrier(bar)
    prologue(kargs(), lds);
    GRID_SYNC();
#pragma unroll 1
    for (int l = 0; l < DEPTH; ++l) {
        {
            KArgs p = kargs(); unsigned char* ws = p->ws;
            pg8::Gemm g{(const bf16_t*)(ws + WS_HB), (const bf16_t*)(ws + WS_W) + (size_t)l * LAYER_W_ELEMS + OW1, MPAD, 2 * FF, D}; pg8::StaticOrder S; S.init(MPAD, 2 * FF, G, bid);
            EpiSwiglu E{(bf16_t*)(ws + WS_R), (const float*)(ws + WS_STAT) + (size_t)(3 * l) * MPAD};
            pg8::gemm_phase<EpiSwiglu, true>(lds, g, S, E);
        }
        GRID_SYNC();
        {
            KArgs p = kargs(); unsigned char* ws = p->ws; float* H = p->out;
            pg8::Gemm g{(const bf16_t*)(ws + WS_R), (const bf16_t*)(ws + WS_W) + (size_t)l * LAYER_W_ELEMS + OW2, MPAD, D, FF}; pg8::StaticOrder S; S.init(MPR, D, G, bid);
            EpiResid E{l == 0 ? p->in[I_XP] : H, l == 0 ? p->in[I_XS] : H + (size_t)MPR * D, H, (bf16_t*)(ws + WS_HB), (float*)(ws + WS_STAT) + (size_t)(3 * l + 1) * MPAD, 0.5f};
            for (int it = bid; it < 256; it += G) skinny_resid<22, 11>(lds, g.A, g.Bt, it, E);
            pg8::gemm_phase<EpiResid, true>(lds, g, S, E);
        }
        GRID_SYNC();
        {
            KArgs p = kargs(); unsigned char* ws = p->ws;
            pg8::Gemm g{(const bf16_t*)(ws + WS_HB), (const bf16_t*)(ws + WS_W) + (size_t)l * LAYER_W_ELEMS + OWIN, MPAD, NIN, D}; pg8::StaticOrder S; S.init(MPAD, NIN, G, bid);
            EpiMixIn E{(bf16_t*)(ws + WS_R), (const float*)(ws + WS_STAT) + (size_t)(3 * l + 1) * MPAD, p->in[I_BIN] + (size_t)l * NIN, (float*)(ws + WS_STAT) + (size_t)(7 + 2 * l) * MPAD,
                       p->out + O_NCP + (size_t)l * NB * 2 * D, l};
            pg8::gemm_phase<EpiMixIn, true>(lds, g, S, E);
        }
        GRID_SYNC();
        {
            KArgs p = kargs();
            for (int it = bid; it < 516; it += G) {
                if (it < 512) mix_prompt_item(p, lds, l, it >> 2, it & 3); else mix_sample_item(p, l, it - 512);
            }
        }
        GRID_SYNC();
        {
            KArgs p = kargs(); unsigned char* ws = p->ws; float* H = p->out;
            pg8::Gemm g{(const bf16_t*)(ws + WS_R), (const bf16_t*)(ws + WS_W) + (size_t)l * LAYER_W_ELEMS + OWO, MPAD, D, D}; pg8::StaticOrder S; S.init(MPR, D, G, bid);
            EpiResid E{H, H + (size_t)MPR * D, H, (bf16_t*)(ws + WS_HB), (float*)(ws + WS_STAT) + (size_t)(3 * l + 2) * MPAD, 1.0f};
            for (int it = bid; it < 256; it += G) skinny_resid<8, 8>(lds, g.A, g.Bt, it, E);
            pg8::gemm_phase<EpiResid, true>(lds, g, S, E);
        }
        GRID_SYNC();
        {
            KArgs p = kargs(); unsigned char* ws = p->ws;
            pg8::Gemm g{(const bf16_t*)(ws + WS_HB), (const bf16_t*)(ws + WS_W) + (size_t)l * LAYER_W_ELEMS + OW6, MPAD, 2 * FF, D}; pg8::StaticOrder S; S.init(MPAD, 2 * FF, G, bid);
            EpiSwiglu E{(bf16_t*)(ws + WS_R), (const float*)(ws + WS_STAT) + (size_t)(3 * l + 2) * MPAD};
            pg8::gemm_phase<EpiSwiglu, true>(lds, g, S, E);
        }
        GRID_SYNC();
        {
            KArgs p = kargs(); unsigned char* ws = p->ws; float* H = p->out;
            pg8::Gemm g{(const bf16_t*)(ws + WS_R), (const bf16_t*)(ws + WS_W) + (size_t)l * LAYER_W_ELEMS + OW7, MPAD, D, FF}; pg8::StaticOrder S; S.init(MPR, D, G, bid);
            EpiResid E{H, H + (size_t)MPR * D, H, (bf16_t*)(ws + WS_HB), (float*)(ws + WS_STAT) + (size_t)(3 * l + 3) * MPAD, 0.5f};
            for (int it = bid; it < 256; it += G) skinny_resid<22, 11>(lds, g.A, g.Bt, it, E);
            pg8::gemm_phase<EpiResid, true>(lds, g, S, E);
        }
        GRID_SYNC();
    }
    {
        KArgs p = kargs();
        const int tid = threadIdx.x, lane = tid & 63, wave = tid >> 6;
        const float* rsf = (const float*)(p->ws + WS_STAT) + (size_t)6 * MPAD;
        const f32x4* fn4 = (const f32x4*)p->in[I_FN] + lane;
        float* H = p->out;
        for (int r = bid * 8 + wave; r < M; r += G * 8) {
            const float rs = __builtin_amdgcn_rsqf(rsf[r] * (1.0f / D) + EPS);
            f32x4* y = (f32x4*)(H + (size_t)r * D) + lane;
#pragma unroll
            for (int j = 0; j < 4; ++j) y[64 * j] = y[64 * j] * rs * fn4[64 * j];
        }
    }
}

extern "C" void kernel_launch(void* const* d_in, const int* in_sizes, int n_in, void* d_out, int out_size, void* d_ws, size_t ws_size, hipStream_t stream) {
    static int grid = 0;
    if (grid == 0) {
        if (n_in != 21 || ws_size < WS_END) { fprintf(stderr, "kernel_launch: bad setup n_in %d ws %zu (need %zu)\n", n_in, ws_size, (size_t)WS_END); grid = -1; return; }
        int dev = 0, cus = 0, per_cu = 0;
        (void)hipGetDevice(&dev);
        (void)hipDeviceGetAttribute(&cus, hipDeviceAttributeMultiprocessorCount, dev);
        (void)hipFuncSetAttribute((const void*)fwd_megakernel, hipFuncAttributeMaxDynamicSharedMemorySize, LDS_BYTES);
        (void)hipOccupancyMaxActiveBlocksPerMultiprocessor(&per_cu, (const void*)fwd_megakernel, 512, LDS_BYTES);
        if (per_cu < 1) per_cu = 1;
        grid = cus * per_cu;
        (void)hipGetLastError();
    }
    if (grid < 0) return;
    if (hipMemsetAsync((char*)d_ws + WS_BAR, 0, BAR_BYTES, stream) != hipSuccess) { fprintf(stderr, "memset failed\n"); return; }
    Args a{};
    for (int i = 0; i < 21; ++i) a.in[i] = (const float*)d_in[i];
    a.out = (float*)d_out; a.ws = (unsigned char*)d_ws;
    void* args[] = {&a};
    hipError_t e = hipLaunchCooperativeKernel((const void*)fwd_megakernel, dim3(grid), dim3(512), args, LDS_BYTES, stream);
    if (e != hipSuccess) fprintf(stderr, "cooperative launch failed: %s (grid %d)\n", hipGetErrorString(e), grid);
}
```

```cpp
#include <hip/hip_runtime.h>
#include <hip/hip_cooperative_groups.h>
#include <cstdio>
#include <cstdint>
namespace cg = cooperative_groups;

#define LAS __attribute__((address_space(3)))
typedef unsigned short bf16_t;
typedef short bf16x8 __attribute__((ext_vector_type(8)));
typedef float f32x4 __attribute__((ext_vector_type(4)));
typedef float f32x2 __attribute__((ext_vector_type(2)));
typedef unsigned u32x4 __attribute__((ext_vector_type(4)));
typedef unsigned u32x2 __attribute__((ext_vector_type(2)));

constexpr int D = 1024, FF = 2816, NIN = 7168, SEQ = 2048, NB = 8, NS = 128, DEPTH = 2;
constexpr int MPR = NB * SEQ;
constexpr int M = MPR + NS;
constexpr int MPAD = 16640;
constexpr float EPS = 1e-6f;
constexpr size_t O_Y = 0, O_NCP = (size_t)M * D, O_NCS = O_NCP + (size_t)DEPTH * NB * 2 * D, O_VS = O_NCS + (size_t)DEPTH * NS * 2 * D;
constexpr size_t MiB = 1u << 20;
constexpr size_t WS_STAT = 0;
constexpr size_t WS_BAR = 768 * 1024, BAR_BYTES = 16384;
constexpr size_t WS_W = 1 * MiB;
constexpr size_t LAYER_W_ELEMS = 25690112;
constexpr size_t OW1 = 0, OW2 = 5767168, OWIN = 8650752, OWO = 15990784, OW6 = 17039360, OW7 = 22806528;
constexpr size_t WS_HB = 99 * MiB;
constexpr size_t ACT_BYTES = (size_t)MPAD * D * 2;
constexpr size_t WS_R = WS_HB + ACT_BYTES;
constexpr size_t WS_END = WS_R + 4 * ACT_BYTES;
constexpr int LDS_BYTES = 148480;

__device__ __forceinline__ unsigned cvt_pk_bf16(float lo, float hi) { unsigned r; asm("v_cvt_pk_bf16_f32 %0, %1, %2" : "=v"(r) : "v"(lo), "v"(hi)); return r; }
__device__ __forceinline__ float bf_lo(unsigned w) { return __uint_as_float(w << 16); }
__device__ __forceinline__ float bf_hi(unsigned w) { return __uint_as_float(w & 0xffff0000u); }
__device__ __forceinline__ float sigmoidf_(float x) { return __builtin_amdgcn_rcpf(1.0f + __builtin_amdgcn_exp2f(-1.44269504089f * x)); }
__device__ __forceinline__ float siluf_(float x) { return x * sigmoidf_(x); }
__device__ __forceinline__ f32x2 gelu_pk(f32x2 v) {
    const f32x2 av = __builtin_elementwise_abs(v), d = av * 0.2316418882f + 1.0f;
    f32x2 t; t.x = __builtin_amdgcn_rcpf(d.x); t.y = __builtin_amdgcn_rcpf(d.y);
    f32x2 q = t * 0.5307027145f + (-0.7265760135f); q = q * t + 0.7107068705f; q = q * t + (-0.142248368f); q = q * t + 0.127414796f; q = q * t;
    const f32x2 s = (v * v) * (-0.72134752044f);
    f32x2 e; e.x = __builtin_amdgcn_exp2f(s.x); e.y = __builtin_amdgcn_exp2f(s.y);
    const f32x2 m = v * (q * e), r = v - m;
    f32x2 o; o.x = v.x < 0.f ? m.x : r.x; o.y = v.y < 0.f ? m.y : r.y; return o;
}
__device__ __forceinline__ f32x4 gelu4(f32x4 v) { f32x2 a = gelu_pk((f32x2){v[0], v[1]}), b = gelu_pk((f32x2){v[2], v[3]}); return (f32x4){a.x, a.y, b.x, b.y}; }
__device__ __forceinline__ float wave_sum(float v) {
#pragma unroll
    for (int o = 1; o < 64; o <<= 1) v += __shfl_xor(v, o);
    return v;
}

namespace pg8 {
constexpr int BM = 256, BK = 64, HALF = 128, HTB = HALF * BK * 2, STAGE_BYTES = 8 * HTB, NXCD = 8, WGM = 8;
constexpr int PRE_OFF = STAGE_BYTES, PRE_SLOT = 2048;
__host__ __device__ __forceinline__ int lds_byte(int r, int c) { const int st = (r >> 4) * 2 + (c >> 5), rr = r & 15, cc = c & 31, ob = rr * 64 + cc * 2; return st * 1024 + (ob ^ (((ob >> 9) & 1) << 5)); }
__host__ __device__ __forceinline__ void stage_rc(int b, int& R, int& C) { const int st = b / 1024, sb = b % 1024, swz = sb ^ (((sb >> 9) & 1) << 5); R = (st >> 1) * 16 + swz / 64; C = (st & 1) * 32 + (swz % 64) / 2; }
__host__ __device__ __forceinline__ int perm32(int rho) { const int n = rho >> 4, i = rho & 15; return 8 * (i >> 2) + 4 * n + (i & 3); }
struct Unit { int pm, pn; };
struct Gemm { const bf16_t* A; const bf16_t* Bt; int M, N, K; };
struct StaticOrder {
    int nM, nN, nwg, G, c;
    __device__ void init(int M_, int N_, int G_, int c_) { nM = M_ / BM; nN = N_ / BM; nwg = nM * nN; G = G_; c = c_; }
    __device__ bool next(int i, Unit& u) const {
        const long L = (long)i * G + c; if (L >= nwg) return false;
        int wgid = (int)L; { const int q = nwg / NXCD, r = nwg % NXCD, xcd = wgid % NXCD, off = wgid / NXCD; wgid = (xcd < r ? xcd * (q + 1) : r * (q + 1) + (xcd - r) * q) + off; }
        const int nig = WGM * nN, gid = wgid / nig, fm = gid * WGM, gsz = (nM - fm) < WGM ? (nM - fm) : WGM;
        u.pm = fm + ((wgid % nig) % gsz); u.pn = (wgid % nig) / gsz; return true;
    }
};

template <class Epi, bool ALIGN_EPI>
__device__ __forceinline__ void gemm_phase(LAS unsigned char* lds, const Gemm g, const StaticOrder& S, const Epi& E) {
    int tid_ = threadIdx.x; asm volatile("" : "+v"(tid_));
    const int tid = tid_, wid = __builtin_amdgcn_readfirstlane(tid >> 6), lane = tid & 63, wr = wid >> 2, wc = wid & 3, fr = lane & 15, fq = lane >> 4;
    const int K = g.K, nt = K / BK;
    unsigned voffA[2], voffB[2];
#pragma unroll
    for (int i = 0; i < 2; ++i) { int R, C; stage_rc(tid * 16 + i * 8192, R, C); const int Rb = Epi::PERM ? ((R & ~31) + perm32(R & 31)) : R;
        voffA[i] = (unsigned)(R * K + C) * 2u; voffB[i] = (unsigned)(Rb * K + C) * 2u; }
    const size_t kstep = (size_t)(BK * 2);
    const size_t hstep = (size_t)HALF * K * 2;
    const size_t tstep = 2 * hstep;
    const unsigned ldsw = (unsigned)wid * 1024u;
    const int aoff = lds_byte(wr * 64 + fr, fq * 8), boff = lds_byte(wc * 32 + fr, fq * 8);
#define PG8_SA(b, h) (((b) * 2 + (h)) * HTB)
#define PG8_SB(b, h) ((4 + (b) * 2 + (h)) * HTB)
#define PG8_STAGE(bufoff, gbase, voff) do { _Pragma("unroll") for (int _i = 0; _i < 2; ++_i) \
        __builtin_amdgcn_global_load_lds((const unsigned*)((const char*)(gbase) + (voff)[_i]), (LAS unsigned*)(lds + (bufoff) + ldsw + _i * 8192), 16, 0, 0); } while (0)
#define PG8_LDA(dst, b, h) do { _Pragma("unroll") for (int m = 0; m < 4; ++m) _Pragma("unroll") for (int k = 0; k < 2; ++k) dst[m][k] = *(const LAS bf16x8*)(lds + PG8_SA(b, h) + aoff + m * 2048 + k * 1024); } while (0)
#define PG8_LDB(dst, b, h) do { _Pragma("unroll") for (int n = 0; n < 2; ++n) _Pragma("unroll") for (int k = 0; k < 2; ++k) dst[n][k] = *(const LAS bf16x8*)(lds + PG8_SB(b, h) + boff + n * 2048 + k * 1024); } while (0)
#define PG8_MMA(ai, bj, At, Bt) do { __builtin_amdgcn_s_setprio(1); _Pragma("unroll") for (int m = 0; m < 4; ++m) _Pragma("unroll") for (int n = 0; n < 2; ++n) _Pragma("unroll") for (int k = 0; k < 2; ++k) \
        acc[ai][bj][m][n] = __builtin_amdgcn_mfma_f32_16x16x32_bf16(Bt[n][k], At[m][k], acc[ai][bj][m][n], 0, 0, 0); __builtin_amdgcn_s_setprio(0); } while (0)
#define PG8_WAIT_V(n) asm volatile("s_waitcnt vmcnt(" #n ")" ::: "memory")
#define PG8_WAIT_L(n) asm volatile("s_waitcnt lgkmcnt(" #n ")" ::: "memory")
#define PG8_BAR __builtin_amdgcn_s_barrier()
#define PG8_SCHED __builtin_amdgcn_sched_barrier(0)
    Unit cur, nxt; int ui = 0;
    if (!S.next(0, cur)) return;
    f32x4 acc[2][2][4][2];
#pragma unroll
    for (int a = 0; a < 2; ++a)
#pragma unroll
        for (int b = 0; b < 2; ++b)
#pragma unroll
            for (int m = 0; m < 4; ++m)
#pragma unroll
                for (int n = 0; n < 2; ++n) acc[a][b][m][n] = (f32x4){0.f, 0.f, 0.f, 0.f};
    bf16x8 At[4][2], B0[2][2], B1[2][2];
    const char* cA = (const char*)g.A + (size_t)cur.pm * tstep; const char* cB = (const char*)g.Bt + (size_t)cur.pn * tstep;
    if constexpr (Epi::PRE) E.pre(cur, lds + PRE_OFF, wid, lane);
    PG8_STAGE(PG8_SB(0, 0), cB, voffB); PG8_STAGE(PG8_SB(0, 1), cB + hstep, voffB); PG8_STAGE(PG8_SA(0, 0), cA, voffA); PG8_STAGE(PG8_SA(0, 1), cA + hstep, voffA);
    if (wr == 1) PG8_BAR;
    PG8_WAIT_V(2); PG8_BAR;
    PG8_STAGE(PG8_SB(1, 0), cB + kstep, voffB); PG8_STAGE(PG8_SA(1, 0), cA + kstep, voffA); PG8_STAGE(PG8_SB(1, 1), cB + hstep + kstep, voffB);
    PG8_WAIT_V(6); PG8_BAR;
    for (;;) {
        const bool has_next = S.next(ui + 1, nxt);
        const char* nA = has_next ? (const char*)g.A + (size_t)nxt.pm * tstep : cA; const char* nB = has_next ? (const char*)g.Bt + (size_t)nxt.pn * tstep : cB;
        for (int t = 0; t < nt; t += 2) {
            const bool last = (t == nt - 2);
            const char* a1 = cA + (size_t)(t + 1) * kstep;
            const char* a2 = last ? nA : cA + (size_t)(t + 2) * kstep; const char* b2 = last ? nB : cB + (size_t)(t + 2) * kstep;
            const char* a3 = a2 + kstep; const char* b3 = b2 + kstep;
            PG8_LDB(B0, 0, 0); PG8_LDB(B1, 0, 1); PG8_SCHED; PG8_LDA(At, 0, 0); PG8_STAGE(PG8_SA(1, 1), a1 + hstep, voffA);
            PG8_WAIT_V(8); PG8_WAIT_L(0); PG8_BAR; PG8_MMA(0, 0, At, B0); PG8_MMA(0, 1, At, B1); PG8_BAR; PG8_SCHED;
            PG8_LDA(At, 0, 1); PG8_STAGE(PG8_SB(0, 0), b2, voffB); PG8_STAGE(PG8_SB(0, 1), b2 + hstep, voffB); PG8_STAGE(PG8_SA(0, 0), a2, voffA);
            PG8_WAIT_V(8); PG8_WAIT_L(0); PG8_BAR; PG8_MMA(1, 0, At, B0); PG8_MMA(1, 1, At, B1); PG8_BAR; PG8_SCHED;
            PG8_LDB(B0, 1, 0); PG8_LDB(B1, 1, 1); PG8_SCHED; PG8_LDA(At, 1, 0); PG8_STAGE(PG8_SA(0, 1), a2 + hstep, voffA);
            PG8_WAIT_V(8); PG8_WAIT_L(0); PG8_BAR; PG8_MMA(0, 0, At, B0); PG8_MMA(0, 1, At, B1); PG8_BAR; PG8_SCHED;
            PG8_LDA(At, 1, 1); PG8_STAGE(PG8_SB(1, 0), b3, voffB); PG8_STAGE(PG8_SB(1, 1), b3 + hstep, voffB); PG8_STAGE(PG8_SA(1, 0), a3, voffA);
            PG8_WAIT_V(8); PG8_WAIT_L(0); PG8_BAR; PG8_MMA(1, 0, At, B0); PG8_MMA(1, 1, At, B1); PG8_BAR; PG8_SCHED;
        }
        if constexpr (ALIGN_EPI) { if (wr == 0) PG8_BAR; }
        if constexpr (Epi::PRE) E(acc, cur, wr, wc, fr, fq, lds + PRE_OFF + (ui & 1) * PRE_SLOT, lds + 139520);
        else if constexpr (Epi::RED) E(acc, cur, wr, wc, fr, fq, lds + PRE_OFF);
        else E(acc, cur, wr, wc, fr, fq);
        if (!has_next) break;
#pragma unroll
        for (int a = 0; a < 2; ++a)
#pragma unroll
            for (int b = 0; b < 2; ++b)
#pragma unroll
                for (int m = 0; m < 4; ++m)
#pragma unroll
                    for (int n = 0; n < 2; ++n) acc[a][b][m][n] = (f32x4){0.f, 0.f, 0.f, 0.f};
        cur = nxt; cA = nA; cB = nB; ++ui;
        if constexpr (Epi::PRE) E.pre(cur, lds + PRE_OFF + (ui & 1) * PRE_SLOT, wid, lane);
        if constexpr (ALIGN_EPI) { if (wr == 1) PG8_BAR; }
    }
    PG8_WAIT_V(0);
    if constexpr (!ALIGN_EPI) { if (wr == 0) PG8_BAR; }
    PG8_BAR;
#undef PG8_SA
#undef PG8_SB
#undef PG8_STAGE
#undef PG8_LDA
#undef PG8_LDB
#undef PG8_MMA
#undef PG8_WAIT_V
#undef PG8_WAIT_L
#undef PG8_BAR
#undef PG8_SCHED
}
}

constexpr int LAST_PM = MPR / 256;

struct EpiSwiglu {
    static constexpr bool PERM = true, PRE = true, RED = false;
    bf16_t* H; const float* rowss;
    __device__ __forceinline__ void pre(const pg8::Unit& u, LAS unsigned char* slot, int wid, int lane) const {
        if (wid < 4) __builtin_amdgcn_global_load_lds((const unsigned*)(rowss + u.pm * 256 + wid * 64 + lane), (LAS unsigned*)(slot + wid * 256), 4, 0, 0);
    }
    __device__ __forceinline__ void operator()(const f32x4 (&acc)[2][2][4][2], const pg8::Unit& u, int wr, int wc, int fr, int fq, LAS unsigned char* slot, LAS unsigned char*) const {
        const LAS float* rsl = (const LAS float*)slot;
        const int row0 = u.pm * 256 + wr * 64 + fr, col0 = u.pn * 128 + wc * 32 + 8 * fq;
        const int nai = (u.pm == LAST_PM) ? 1 : 2;
#pragma unroll
        for (int ai = 0; ai < 2; ++ai) { if (ai < nai) {
#pragma unroll
            for (int m = 0; m < 4; ++m) {
                const int r = row0 + ai * 128 + m * 16;
                const float rs = __builtin_amdgcn_rsqf(rsl[ai * 128 + wr * 64 + m * 16 + fr] * (1.0f / D) + EPS);
                float h[8];
#pragma unroll
                for (int n = 0; n < 2; ++n) {
                    const f32x4 gq = acc[ai][0][m][n] * rs, uq = acc[ai][1][m][n] * rs, tq = gq * (-1.44269504089f);
                    f32x4 eq; eq[0] = __builtin_amdgcn_exp2f(tq[0]); eq[1] = __builtin_amdgcn_exp2f(tq[1]); eq[2] = __builtin_amdgcn_exp2f(tq[2]); eq[3] = __builtin_amdgcn_exp2f(tq[3]);
                    const f32x4 dq = eq + 1.0f;
                    f32x4 rq; rq[0] = __builtin_amdgcn_rcpf(dq[0]); rq[1] = __builtin_amdgcn_rcpf(dq[1]); rq[2] = __builtin_amdgcn_rcpf(dq[2]); rq[3] = __builtin_amdgcn_rcpf(dq[3]);
                    const f32x4 hq = (gq * uq) * rq;
                    h[n * 4 + 0] = hq[0]; h[n * 4 + 1] = hq[1]; h[n * 4 + 2] = hq[2]; h[n * 4 + 3] = hq[3];
                }
                u32x4 w; w.x = cvt_pk_bf16(h[0], h[1]); w.y = cvt_pk_bf16(h[2], h[3]); w.z = cvt_pk_bf16(h[4], h[5]); w.w = cvt_pk_bf16(h[6], h[7]);
                *(u32x4*)(H + (size_t)r * FF + col0) = w;
            }
        } }
    }
};

struct EpiResid {
    static constexpr bool PERM = true, PRE = false, RED = true;
    const float* xP; const float* xS; bf16_t* HB; float* rowss_next; float scale;
    __device__ __forceinline__ void operator()(const f32x4 (&acc)[2][2][4][2], const pg8::Unit& u, int wr, int wc, int fr, int fq, LAS unsigned char* red) const {
        LAS float* part = (LAS float*)red;
        const int row0 = u.pm * 256 + wr * 64 + fr, col0 = u.pn * 256 + wc * 32 + 8 * fq;
        const int nai = (u.pm == LAST_PM) ? 1 : 2;
#pragma unroll
        for (int ai = 0; ai < 2; ++ai) { if (ai < nai) {
#pragma unroll
            for (int m = 0; m < 4; ++m) {
                const int r = row0 + ai * 128 + m * 16;
                float ss = 0.f;
#pragma unroll
                for (int bj = 0; bj < 2; ++bj) {
                    const int c = col0 + bj * 128;
                    f32x4 b0, b1;
                    if (xP) { const float* b = (r < MPR) ? xP + (size_t)r * D : xS + (size_t)(r - MPR) * D; b0 = *(const f32x4*)(b + c); b1 = *(const f32x4*)(b + c + 4); }
                    else { const u32x4 hw = *(const u32x4*)(HB + (size_t)r * D + c); b0 = (f32x4){bf_lo(hw.x), bf_hi(hw.x), bf_lo(hw.y), bf_hi(hw.y)}; b1 = (f32x4){bf_lo(hw.z), bf_hi(hw.z), bf_lo(hw.w), bf_hi(hw.w)}; }
                    const f32x4 o0 = b0 + acc[ai][bj][m][0] * scale, o1 = b1 + acc[ai][bj][m][1] * scale;
                    ss += (o0[0] * o0[0] + o0[1] * o0[1]) + (o0[2] * o0[2] + o0[3] * o0[3]) + (o1[0] * o1[0] + o1[1] * o1[1]) + (o1[2] * o1[2] + o1[3] * o1[3]);
                    u32x4 w; w.x = cvt_pk_bf16(o0[0], o0[1]); w.y = cvt_pk_bf16(o0[2], o0[3]); w.z = cvt_pk_bf16(o1[0], o1[1]); w.w = cvt_pk_bf16(o1[2], o1[3]);
                    *(u32x4*)(HB + (size_t)r * D + c) = w;
                }
                ss += __shfl_xor(ss, 16); ss += __shfl_xor(ss, 32);
                if (fq == 0) part[wc * 256 + ai * 128 + wr * 64 + m * 16 + fr] = ss;
            }
        } }
        asm volatile("s_waitcnt lgkmcnt(0)" ::: "memory"); __builtin_amdgcn_s_barrier(); asm volatile("" ::: "memory");
        { const int tid = (wr * 4 + wc) * 64 + fq * 16 + fr;
          if (tid < 128 * nai) { const float t = (part[tid] + part[256 + tid]) + (part[512 + tid] + part[768 + tid]); atomicAdd(rowss_next + u.pm * 256 + tid, t); } }
    }
};

struct EpiMixIn {
    static constexpr bool PERM = true, PRE = true, RED = false;
    bf16_t* UG; const float* rowss; const float* bin; float* vsum; float* ncp; int l;
    __device__ __forceinline__ void pre(const pg8::Unit& u, LAS unsigned char* slot, int wid, int lane) const {
        if (wid < 4) __builtin_amdgcn_global_load_lds((const unsigned*)(rowss + u.pm * 256 + wid * 64 + lane), (LAS unsigned*)(slot + wid * 256), 4, 0, 0);
        else { const int type = u.pn >> 3, c = (wid - 4) * 64 + lane;
            int src;
            if (type < 3) { const int o0 = type == 0 ? 0 : (type == 1 ? 3072 : 2048), o1 = type == 0 ? 5120 : (type == 1 ? 4096 : 6144); src = (c < 128 ? o0 : o1) + (u.pn & 7) * 128 + (c & 127); }
            else src = 1024 + (u.pn - 24) * 256 + c;
            __builtin_amdgcn_global_load_lds((const unsigned*)(bin + src), (LAS unsigned*)(slot + 1024 + (wid - 4) * 256), 4, 0, 0); }
    }
    __device__ __forceinline__ void operator()(const f32x4 (&acc)[2][2][4][2], const pg8::Unit& u, int wr, int wc, int fr, int fq, LAS unsigned char* slot, LAS unsigned char* red) const {
        const LAS float* rsl = (const LAS float*)slot; const LAS float* bl = (const LAS float*)(slot + 1024); LAS float* part = (LAS float*)red;
        const int row0 = u.pm * 256 + wr * 64 + fr;
        const int nai = (u.pm == LAST_PM) ? 1 : 2;
        const int type = u.pn >> 3;
        bf16_t* const GV = UG + (size_t)MPAD * D; bf16_t* const XG = GV + (size_t)MPAD * D; bf16_t* const BS = XG + (size_t)MPAD * D;
        float* const vsq = vsum + MPAD; float* const ncs = ncp + (O_NCS - O_NCP) + (size_t)l * (NS - NB) * 2 * D;
        if (type < 3) {
            const int col0 = (u.pn & 7) * 128 + wc * 32 + 8 * fq;
            const int o0 = type == 0 ? 0 : (type == 1 ? 3072 : 2048), o1 = type == 0 ? 5120 : (type == 1 ? 4096 : 6144);
            bf16_t* O = type == 0 ? UG : (type == 1 ? XG : BS);
            const int cb = wc * 32 + 8 * fq;
            const f32x4 b00 = *(const LAS f32x4*)(bl + cb), b01 = *(const LAS f32x4*)(bl + cb + 4);
            const f32x4 b10 = *(const LAS f32x4*)(bl + 128 + cb), b11 = *(const LAS f32x4*)(bl + 128 + cb + 4);
#pragma unroll
            for (int ai = 0; ai < 2; ++ai) { if (ai < nai) {
#pragma unroll
                for (int m = 0; m < 4; ++m) {
                    const int r = row0 + ai * 128 + m * 16;
                    const float rs = __builtin_amdgcn_rsqf(rsl[ai * 128 + wr * 64 + m * 16 + fr] * (1.0f / D) + EPS);
                    f32x4 p0 = acc[ai][0][m][0] * rs + b00, p1 = acc[ai][0][m][1] * rs + b01;
                    f32x4 q0 = acc[ai][1][m][0] * rs + b10, q1 = acc[ai][1][m][1] * rs + b11;
                    f32x4 r0, r1;
                    if (type == 0) { p0 = gelu4(p0); p1 = gelu4(p1);
#pragma unroll
                        for (int j = 0; j < 4; ++j) { r0[j] = p0[j] * sigmoidf_(q0[j]); r1[j] = p1[j] * sigmoidf_(q1[j]); } }
                    else if (type == 1) { r0 = p0 * q0; r1 = p1 * q1;
                        if (r < MPR) { const int t = r & (SEQ - 1); if (t >= SEQ - 2) { float* o = ncp + ((size_t)((r >> 11) * 2 + (t - (SEQ - 2)))) * D + col0; *(f32x4*)o = r0; *(f32x4*)(o + 4) = r1; } }
                        else { float* o = ncs + ((size_t)((r - MPR) * 2 + 1)) * D + col0; *(f32x4*)o = r0; *(f32x4*)(o + 4) = r1; } }
                    else {
#pragma unroll
                        for (int j = 0; j < 4; ++j) { r0[j] = p0[j] * sigmoidf_(q0[j]); r1[j] = p1[j] * sigmoidf_(q1[j]); } }
                    u32x4 w; w.x = cvt_pk_bf16(r0[0], r0[1]); w.y = cvt_pk_bf16(r0[2], r0[3]); w.z = cvt_pk_bf16(r1[0], r1[1]); w.w = cvt_pk_bf16(r1[2], r1[3]);
                    *(u32x4*)(O + (size_t)r * D + col0) = w;
                }
            } }
        } else {
            const int col0 = (u.pn - 24) * 256 + wc * 32 + 8 * fq;
            f32x4 bv[2][2];
#pragma unroll
            for (int bj = 0; bj < 2; ++bj)
#pragma unroll
                for (int n = 0; n < 2; ++n) bv[bj][n] = *(const LAS f32x4*)(bl + bj * 128 + wc * 32 + 8 * fq + 4 * n);
#pragma unroll
            for (int ai = 0; ai < 2; ++ai) { if (ai < nai) {
#pragma unroll
                for (int m = 0; m < 4; ++m) {
                    const int r = row0 + ai * 128 + m * 16;
                    const float rs = __builtin_amdgcn_rsqf(rsl[ai * 128 + wr * 64 + m * 16 + fr] * (1.0f / D) + EPS);
                    float s1 = 0.f, s2 = 0.f;
#pragma unroll
                    for (int bj = 0; bj < 2; ++bj) {
                        f32x4 v0 = gelu4(acc[ai][bj][m][0] * rs + bv[bj][0]), v1 = gelu4(acc[ai][bj][m][1] * rs + bv[bj][1]);
                        s1 += (v0[0] + v0[1]) + (v0[2] + v0[3]) + (v1[0] + v1[1]) + (v1[2] + v1[3]);
                        s2 += (v0[0] * v0[0] + v0[1] * v0[1]) + (v0[2] * v0[2] + v0[3] * v0[3]) + (v1[0] * v1[0] + v1[1] * v1[1]) + (v1[2] * v1[2] + v1[3] * v1[3]);
                        u32x4 w; w.x = cvt_pk_bf16(v0[0], v0[1]); w.y = cvt_pk_bf16(v0[2], v0[3]); w.z = cvt_pk_bf16(v1[0], v1[1]); w.w = cvt_pk_bf16(v1[2], v1[3]);
                        *(u32x4*)(GV + (size_t)r * D + col0 + bj * 128) = w;
                    }
                    s1 += __shfl_xor(s1, 16); s1 += __shfl_xor(s1, 32); s2 += __shfl_xor(s2, 16); s2 += __shfl_xor(s2, 32);
                    if (fq == 0) *(LAS f32x2*)(part + (wc * 256 + ai * 128 + wr * 64 + m * 16 + fr) * 2) = (f32x2){s1, s2};
                }
            } }
            asm volatile("s_waitcnt lgkmcnt(0)" ::: "memory"); __builtin_amdgcn_s_barrier(); asm volatile("" ::: "memory");
            const int tid = (wr * 4 + wc) * 64 + fq * 16 + fr;
            if (tid < 256 * nai) { const float t = (part[tid] + part[512 + tid]) + (part[1024 + tid] + part[1536 + tid]);
                atomicAdd(((tid & 1) ? vsq : vsum) + u.pm * 256 + (tid >> 1), t); }
        }
    }
};


#define XB_TMO      128
#define XB_XCNT(j)  (256  + 64 * (j))
#define XB_XSUB(j)  (1280 + 64 * (j))
#define XB_XGEN(j)  (2304 + 64 * (j))
#define XB_TOP      3328
#define XB_TOPGEN   3392
#define XCD_BAR_WORDS 3456
#define XB_SPIN_CAP (1u << 18)
__device__ __forceinline__ unsigned xb_ld(unsigned* p)              { return __hip_atomic_load(p, __ATOMIC_RELAXED, __HIP_MEMORY_SCOPE_AGENT); }
__device__ __forceinline__ unsigned xb_add(unsigned* p, unsigned v) { return __hip_atomic_fetch_add(p, v, __ATOMIC_RELAXED, __HIP_MEMORY_SCOPE_AGENT); }
__device__ __forceinline__ unsigned xb_xcc_id() { return (unsigned)__builtin_amdgcn_s_getreg((3 << 11) | 20) & 0xFu; }
#define XB_SPIN(cond, bar) do { unsigned _sp = 0; while (cond) { __builtin_amdgcn_s_sleep(1); \
    if ((++_sp & 255u) == 0u) { if (xb_ld(&(bar)[XB_TMO])) break; if (_sp > XB_SPIN_CAP) { atomicAdd(&(bar)[XB_TMO], 1u); break; } } } } while (0)
struct XcdBarrier { unsigned* bar; unsigned x; volatile LAS unsigned* st; };
__device__ __forceinline__ XcdBarrier xcd_barrier_post(unsigned* bar, volatile LAS unsigned* st) {
    XcdBarrier b; b.bar = bar; b.x = xb_xcc_id(); b.st = st;
    if (threadIdx.x == 0) (void)xb_add(&bar[XB_XCNT(b.x)], 1u);
    return b;
}
__device__ __forceinline__ void xcd_barrier_complete(unsigned* bar, unsigned x, unsigned& nloc, unsigned& nx) {
    const unsigned G = gridDim.x * gridDim.y * gridDim.z;
    unsigned sum, cnt, mine, sp = 0u;
    for (;;) {
        sum = 0u; cnt = 0u; mine = 0u;
#pragma unroll
        for (unsigned j = 0; j < 16; ++j) { const unsigned c = xb_ld(&bar[XB_XCNT(j)]); sum += c; cnt += (c > 0u) ? 1u : 0u; mine = (j == x) ? c : mine; }
        if (sum == G) break;
        __builtin_amdgcn_s_sleep(1);
        if ((++sp & 255u) == 0u) { if (xb_ld(&bar[XB_TMO])) break; if (sp > XB_SPIN_CAP) { atomicAdd(&bar[XB_TMO], 1u); break; } }
    }
    nloc = mine > 0u ? mine : 1u; nx = cnt > 0u ? cnt : 1u;
}
__device__ __forceinline__ void xcd_barrier(const XcdBarrier& b) {
    asm volatile("s_waitcnt vmcnt(0)" ::: "memory");
    __syncthreads();
    if (threadIdx.x == 0) {
        unsigned* bar = b.bar;
        __builtin_amdgcn_s_waitcnt(0);
        unsigned nloc = b.st[0], nx = b.st[1];
        if (nloc == 0u) { xcd_barrier_complete(bar, b.x, nloc, nx); b.st[0] = nloc; b.st[1] = nx; }
        const unsigned old = xb_add(&bar[XB_XSUB(b.x)], 1u);
        const unsigned gen = old / nloc;
        if (old + 1u == (gen + 1u) * nloc) {
            __builtin_amdgcn_fence(__ATOMIC_RELEASE, "agent");
            asm volatile("s_waitcnt vmcnt(0)" ::: "memory");
            const unsigned og = xb_add(&bar[XB_TOP], 1u);
            const unsigned tg = og / nx;
            if (og + 1u == (tg + 1u) * nx) xb_add(&bar[XB_TOPGEN], 1u);
            else XB_SPIN(xb_ld(&bar[XB_TOPGEN]) == tg, bar);
            __builtin_amdgcn_fence(__ATOMIC_ACQUIRE, "agent");
            xb_add(&bar[XB_XGEN(b.x)], 1u);
            asm volatile("s_waitcnt vmcnt(0)" ::: "memory");
        } else {
            XB_SPIN(xb_ld(&bar[XB_XGEN(b.x)]) == gen, bar);
            __builtin_amdgcn_fence(__ATOMIC_ACQUIRE, "agent");
            asm volatile("s_waitcnt vmcnt(0)" ::: "memory");
        }
    }
    __syncthreads();
}

constexpr int RED_OFF = 131072, MISC_OFF = RED_OFF + 8192;
template <int NKS  , int CH>
__device__ __forceinline__ void skinny_resid(LAS unsigned char* lds, const bf16_t* A, const bf16_t* Bt, int item, const EpiResid& E) {
    constexpr int K = NKS * 128;
    int tid_ = threadIdx.x; asm volatile("" : "+v"(tid_));
    const int tid = tid_, lane = tid & 63, w = __builtin_amdgcn_readfirstlane(tid >> 6), fr = lane & 15, fq = lane >> 4;
    const int cgn = item >> 2, rh = item & 3, rsub = w & 1, ksp = w >> 1;
    const int rloc = 32 * rh + 16 * rsub + fr;
    const bf16_t* ap = A + (size_t)(MPR + rloc) * K + ksp * (NKS * 32) + 8 * fq;
    const bf16_t* bp = Bt + (size_t)(16 * cgn + fr) * K + ksp * (NKS * 32) + 8 * fq;
    f32x4 acc = (f32x4){0.f, 0.f, 0.f, 0.f};
#pragma unroll 1
    for (int c = 0; c < NKS / CH; ++c) {
        bf16x8 av[CH], bv[CH];
#pragma unroll
        for (int j = 0; j < CH; ++j) { av[j] = *(const bf16x8*)(ap + 32 * (c * CH + j)); bv[j] = *(const bf16x8*)(bp + 32 * (c * CH + j)); }
#pragma unroll
        for (int j = 0; j < CH; ++j) acc = __builtin_amdgcn_mfma_f32_16x16x32_bf16(bv[j], av[j], acc, 0, 0, 0);
    }
    LAS f32x4* red = (LAS f32x4*)(lds + RED_OFF);
    red[w * 64 + lane] = acc;
    __syncthreads();
    if (ksp == 0) {
        acc = acc + red[(w + 2) * 64 + lane] + red[(w + 4) * 64 + lane] + red[(w + 6) * 64 + lane];
        const int r = MPR + rloc, c = 16 * cgn + 4 * fq;
        f32x4 bs;
        if (E.xS) bs = *(const f32x4*)(E.xS + (size_t)rloc * D + c);
        else { const u32x2 hw = *(const u32x2*)(E.HB + (size_t)r * D + c); bs = (f32x4){bf_lo(hw.x), bf_hi(hw.x), bf_lo(hw.y), bf_hi(hw.y)}; }
        const f32x4 o = bs + acc * E.scale;
        float ss = (o[0] * o[0] + o[1] * o[1]) + (o[2] * o[2] + o[3] * o[3]);
        u32x2 wv; wv.x = cvt_pk_bf16(o[0], o[1]); wv.y = cvt_pk_bf16(o[2], o[3]);
        *(u32x2*)(E.HB + (size_t)r * D + c) = wv;
        ss += __shfl_xor(ss, 16); ss += __shfl_xor(ss, 32);
        if (fq == 0) atomicAdd(E.rowss_next + r, ss);
    }
    __syncthreads();
}

__device__ __forceinline__ void skinny_mixin(const bf16_t* A, const bf16_t* Bt, int item, const EpiMixIn& E) {
    int tid_ = threadIdx.x; asm volatile("" : "+v"(tid_));
    const int tid = tid_, lane = tid & 63, w = __builtin_amdgcn_readfirstlane(tid >> 6), fr = lane & 15, fq = lane >> 4;
    const int type = item >> 6, ch0 = (item & 63) * 16;
    const int brow0 = (type < 3) ? (type * 8 + (ch0 >> 7)) * 256 + (ch0 & 127) : 24 * 256 + ch0;
    const bf16_t* ap = A + (size_t)(MPR + 16 * w + fr) * D + 8 * fq;
    const bf16_t* bp0 = Bt + (size_t)(brow0 + fr) * D + 8 * fq;
    const bf16_t* bp1 = bp0 + (size_t)128 * D;
    f32x4 acc0 = (f32x4){0.f, 0.f, 0.f, 0.f}, acc1 = acc0;
    if (type < 3) {
#pragma unroll 1
        for (int c = 0; c < 4; ++c) {
            bf16x8 av[8], bv0[8], bv1[8];
#pragma unroll
            for (int j = 0; j < 8; ++j) { av[j] = *(const bf16x8*)(ap + 32 * (c * 8 + j)); bv0[j] = *(const bf16x8*)(bp0 + 32 * (c * 8 + j)); bv1[j] = *(const bf16x8*)(bp1 + 32 * (c * 8 + j)); }
#pragma unroll
            for (int j = 0; j < 8; ++j) { acc0 = __builtin_amdgcn_mfma_f32_16x16x32_bf16(bv0[j], av[j], acc0, 0, 0, 0); acc1 = __builtin_amdgcn_mfma_f32_16x16x32_bf16(bv1[j], av[j], acc1, 0, 0, 0); }
        }
    } else {
#pragma unroll 1
        for (int c = 0; c < 4; ++c) {
            bf16x8 av[8], bv0[8];
#pragma unroll
            for (int j = 0; j < 8; ++j) { av[j] = *(const bf16x8*)(ap + 32 * (c * 8 + j)); bv0[j] = *(const bf16x8*)(bp0 + 32 * (c * 8 + j)); }
#pragma unroll
            for (int j = 0; j < 8; ++j) acc0 = __builtin_amdgcn_mfma_f32_16x16x32_bf16(bv0[j], av[j], acc0, 0, 0, 0);
        }
    }
    const int sidx = 16 * w + fr, r = MPR + sidx, ch = ch0 + 4 * fq;
    const float rs = __builtin_amdgcn_rsqf(E.rowss[r] * (1.0f / D) + EPS);
    bf16_t* const GV = E.UG + (size_t)MPAD * D; bf16_t* const XG = GV + (size_t)MPAD * D; bf16_t* const BS = XG + (size_t)MPAD * D;
    if (type < 3) {
        const int o0 = type == 0 ? 0 : (type == 1 ? 3072 : 2048), o1 = type == 0 ? 5120 : (type == 1 ? 4096 : 6144);
        f32x4 p = acc0 * rs + *(const f32x4*)(E.bin + o0 + ch), q = acc1 * rs + *(const f32x4*)(E.bin + o1 + ch), res;
        if (type == 0) { p = gelu4(p);
#pragma unroll
            for (int j = 0; j < 4; ++j) res[j] = p[j] * sigmoidf_(q[j]); }
        else if (type == 1) { res = p * q; float* ncs = E.ncp + (O_NCS - O_NCP) + (size_t)E.l * (NS - NB) * 2 * D; *(f32x4*)(ncs + ((size_t)(sidx * 2 + 1)) * D + ch) = res; }
        else {
#pragma unroll
            for (int j = 0; j < 4; ++j) res[j] = p[j] * sigmoidf_(q[j]); }
        bf16_t* O = type == 0 ? E.UG : (type == 1 ? XG : BS);
        u32x2 wv; wv.x = cvt_pk_bf16(res[0], res[1]); wv.y = cvt_pk_bf16(res[2], res[3]);
        *(u32x2*)(O + (size_t)r * D + ch) = wv;
    } else {
        const f32x4 v = gelu4(acc0 * rs + *(const f32x4*)(E.bin + 1024 + ch));
        float s1 = (v[0] + v[1]) + (v[2] + v[3]), s2 = (v[0] * v[0] + v[1] * v[1]) + (v[2] * v[2] + v[3] * v[3]);
        u32x2 wv; wv.x = cvt_pk_bf16(v[0], v[1]); wv.y = cvt_pk_bf16(v[2], v[3]);
        *(u32x2*)(GV + (size_t)r * D + ch) = wv;
        s1 += __shfl_xor(s1, 16); s1 += __shfl_xor(s1, 32); s2 += __shfl_xor(s2, 16); s2 += __shfl_xor(s2, 32);
        if (fq == 0) { atomicAdd(E.vsum + r, s1); atomicAdd(E.vsum + MPAD + r, s2); }
    }
}

struct Args { const float* in[21]; float* out; unsigned char* ws; };
typedef const __attribute__((address_space(4))) Args* KArgs;
__device__ __forceinline__ KArgs kargs() { KArgs p = (KArgs)__builtin_amdgcn_kernarg_segment_ptr(); asm volatile("" : "+s"(p)); return p; }
enum { I_XP = 0, I_XS, I_STATE, I_F1N, I_F1G, I_F1U, I_F1D, I_MIXN, I_WIN, I_BIN, I_VG, I_VB, I_WSP, I_BSP, I_CW, I_WO, I_F2N, I_F2G, I_F2U, I_F2D, I_FN };

__device__ __forceinline__ void transpose_item(const float* W, int N, int srccol0, const float* gain, bf16_t* WT, int K, int destrow0, int k0, int lane) {
    const int nq = lane & 15, ko = lane >> 4;
#pragma unroll
    for (int h = 0; h < 2; ++h) {
        const int kb = k0 + 32 * h + 8 * ko;
        f32x4 v[8];
#pragma unroll
        for (int j = 0; j < 8; ++j) v[j] = *(const f32x4*)(W + (size_t)(kb + j) * N + srccol0 + 4 * nq);
        if (gain) { const f32x4 g0 = *(const f32x4*)(gain + kb), g1 = *(const f32x4*)(gain + kb + 4);
#pragma unroll
            for (int j = 0; j < 4; ++j) { v[j] = v[j] * g0[j]; v[4 + j] = v[4 + j] * g1[j]; } }
#pragma unroll
        for (int i = 0; i < 4; ++i) { u32x4 o; o.x = cvt_pk_bf16(v[0][i], v[1][i]); o.y = cvt_pk_bf16(v[2][i], v[3][i]); o.z = cvt_pk_bf16(v[4][i], v[5][i]); o.w = cvt_pk_bf16(v[6][i], v[7][i]);
            *(u32x4*)(WT + (size_t)(destrow0 + 4 * nq + i) * K + kb) = o; }
    }
}
__device__ __forceinline__ int win_srccol(int nprime) {
    const int pn = nprime >> 8, w = nprime & 255, half = w >> 7, cw = w & 127;
    if (pn < 8) return (half ? 5120 : 0) + 128 * pn + cw;
    if (pn < 16) return (half ? 4096 : 3072) + 128 * (pn - 8) + cw;
    if (pn < 24) return (half ? 6144 : 2048) + 128 * (pn - 16) + cw;
    return 1024 + 256 * (pn - 24) + w;
}
constexpr int IT_W1 = 16 * 88, IT_W2 = 44 * 16, IT_WIN = 16 * 112, IT_WO = 16 * 16, IT_LAYER = 2 * IT_W1 + 2 * IT_W2 + IT_WIN + IT_WO;


__device__ __forceinline__ void convert_item(KArgs a, int l, int mat, int r, int lane) {
    bf16_t* WL = (bf16_t*)(a->ws + WS_W) + (size_t)l * LAYER_W_ELEMS;
    if (mat == 0 || mat == 4) { const int which = mat == 4; const int kb = r / 88, nb = r % 88, np = 64 * nb, pn = np >> 8, w = np & 255, half = w >> 7, cw = w & 127;
        const float* src = a->in[which ? (half ? I_F2U : I_F2G) : (half ? I_F1U : I_F1G)] + (size_t)l * D * FF;
        transpose_item(src, FF, 128 * pn + cw, a->in[which ? I_F2N : I_F1N] + l * D, WL + (which ? OW6 : OW1), D, np, 64 * kb, lane); }
    else if (mat == 1 || mat == 5) { const int which = mat == 5; const int kb = r / 16, nb = r % 16;
        transpose_item(a->in[which ? I_F2D : I_F1D] + (size_t)l * FF * D, D, 64 * nb, nullptr, WL + (which ? OW7 : OW2), FF, 64 * nb, 64 * kb, lane); }
    else if (mat == 2) { const int kb = r / 112, nb = r % 112;
        transpose_item(a->in[I_WIN] + (size_t)l * D * NIN, NIN, win_srccol(64 * nb), a->in[I_MIXN] + l * D, WL + OWIN, D, 64 * nb, 64 * kb, lane); }
    else { const int kb = r / 16, nb = r % 16;
        transpose_item(a->in[I_WO] + (size_t)l * D * D, D, 64 * nb, nullptr, WL + OWO, D, 64 * nb, 64 * kb, lane); }
}
__device__ __forceinline__ void convert_group(KArgs a, int grp, int slot, int nslots, int lane) {
    int sl[4] = {0, 0, 0, 0}, sm[4] = {0, 0, 0, 0}, sn[4] = {0, 0, 0, 0};
    if (grp == 0)      { sl[0] = 0; sm[0] = 0; sn[0] = IT_W1;  sl[1] = 0; sm[1] = 4; sn[1] = IT_W1; }
    else if (grp == 1) { sl[0] = 0; sm[0] = 1; sn[0] = IT_W2;  sl[1] = 0; sm[1] = 2; sn[1] = IT_WIN; sl[2] = 0; sm[2] = 3; sn[2] = IT_WO; }
    else if (grp == 2) { sl[0] = 0; sm[0] = 5; sn[0] = IT_W2;  sl[1] = 1; sm[1] = 0; sn[1] = IT_W1;  sl[2] = 1; sm[2] = 1; sn[2] = IT_W2;  sl[3] = 1; sm[3] = 4; sn[3] = IT_W1; }
    else if (grp == 3) { sl[0] = 1; sm[0] = 2; sn[0] = IT_WIN; sl[1] = 1; sm[1] = 3; sn[1] = IT_WO; }
    else               { sl[0] = 1; sm[0] = 5; sn[0] = IT_W2; }
    const int total = sn[0] + sn[1] + sn[2] + sn[3];
    for (int q = slot; q < total; q += nslots) {
        int r = q, l = sl[0], m = sm[0];
        if (r >= sn[0]) { r -= sn[0]; l = sl[1]; m = sm[1];
            if (r >= sn[1]) { r -= sn[1]; l = sl[2]; m = sm[2];
                if (r >= sn[2]) { r -= sn[2]; l = sl[3]; m = sm[3]; } } }
        convert_item(a, l, m, r, lane);
    }
}
constexpr int N_GU_UNITS = (MPAD / 256) * (2 * FF / 256);
__device__ __forceinline__ void convert_in_tail(KArgs a, int grp, int G, int bid) {
    int tid_ = threadIdx.x; asm volatile("" : "+v"(tid_));
    const int lane = tid_ & 63, wave = tid_ >> 6, rem = N_GU_UNITS % G;
    if (rem == 0) convert_group(a, grp, bid * 8 + wave, G * 8, lane);
    else if (bid >= rem) convert_group(a, grp, (bid - rem) * 8 + wave, (G - rem) * 8, lane);
}

__device__ __forceinline__ void prologue(KArgs a, LAS unsigned char* lds) {
    const int tid = threadIdx.x, lane = tid & 63, wave = tid >> 6;
    const int gw = blockIdx.x * 8 + wave, NGW = gridDim.x * 8;
    float* stat = (float*)(a->ws + WS_STAT);
    for (size_t i = (size_t)blockIdx.x * 512 + tid; i < (size_t)10 * MPAD; i += (size_t)gridDim.x * 512) stat[MPAD + i] = 0.f;
    if (blockIdx.x == 0 && tid < MPAD - M) stat[M + tid] = 0.f;
    bf16_t* HB = (bf16_t*)(a->ws + WS_HB);
    for (int r = gw; r < M; r += NGW) {
        const float* xr = (r < MPR) ? a->in[I_XP] + (size_t)r * D : a->in[I_XS] + (size_t)(r - MPR) * D;
        const f32x4* x4 = (const f32x4*)xr + lane;
        unsigned long long* o8 = (unsigned long long*)(HB + (size_t)r * D) + lane;
        float s = 0.f;
#pragma unroll
        for (int j = 0; j < 4; ++j) { const f32x4 v = x4[64 * j]; s += (v[0] * v[0] + v[1] * v[1]) + (v[2] * v[2] + v[3] * v[3]);
            o8[64 * j] = (unsigned long long)cvt_pk_bf16(v[0], v[1]) | ((unsigned long long)cvt_pk_bf16(v[2], v[3]) << 32); }
        s = wave_sum(s);
        if (lane == 0) stat[r] = s;
    }
    for (int i = blockIdx.x * 512 + tid; i < DEPTH * NS * (D / 4); i += gridDim.x * 512) {
        const int ls = i / (D / 4), c4 = i % (D / 4);
        *((f32x4*)(a->out + O_NCS + (size_t)(ls * 2) * D) + c4) = *((const f32x4*)(a->in[I_STATE] + (size_t)(ls * 2 + 1) * D) + c4);
    }
    convert_group(a, 0, gw, NGW, lane);
}

constexpr int T_OFF = 0, W_OFF = 65536, WROW = 272, Z_OFF = 0, ZROW = 1040, ST_OFF = 133120, BSP_OFF = ST_OFF + 1024;
__device__ __forceinline__ int tsw(int d) { const int v = d & 15; return (v ^ ((v >> 3) << 2)) ^ ((d >> 4) & 15); }
__device__ __forceinline__ void mix_prompt_item(KArgs a, LAS unsigned char* lds, int l, int chunk, int g) {
    int tid_ = threadIdx.x; asm volatile("" : "+v"(tid_));
    const int tid = tid_, lane = tid & 63, wave = __builtin_amdgcn_readfirstlane(tid >> 6), fr = lane & 15, fq = lane >> 4;
    float* stat = (float*)(a->ws + WS_STAT);
    const float* vsum = stat + (size_t)(7 + 2 * l) * MPAD; const float* vsq = vsum + MPAD;
    bf16_t* UG = (bf16_t*)(a->ws + WS_R); const bf16_t* GV = UG + (size_t)MPAD * D; const bf16_t* XG = GV + (size_t)MPAD * D; const bf16_t* BS = XG + (size_t)MPAD * D;
    const int row0 = chunk * 128;
    LAS float* st = (LAS float*)(lds + ST_OFF);
    LAS float* bspL = (LAS float*)(lds + BSP_OFF);
    if (tid < 128) { const int r = row0 + tid; const float mean = vsum[r] * (1.0f / D); const float var = fmaxf(vsq[r] * (1.0f / D) - mean * mean, 0.f);
        st[2 * tid] = mean; st[2 * tid + 1] = __builtin_amdgcn_rsqf(var + EPS); }
    else if (tid < 256) bspL[tid - 128] = a->in[I_BSP][(l * 4 + g) * 128 + (tid - 128)];
    {
        const int t = tid >> 2, s0 = (tid & 3) * 32; const float* wp = a->in[I_WSP] + ((size_t)(l * 4 + g) * 128 + t) * 128 + s0;
#pragma unroll
        for (int q = 0; q < 4; ++q) { const f32x4 w0 = *(const f32x4*)(wp + 8 * q), w1 = *(const f32x4*)(wp + 8 * q + 4); float e[8] = {w0[0], w0[1], w0[2], w0[3], w1[0], w1[1], w1[2], w1[3]};
#pragma unroll
            for (int j = 0; j < 8; ++j) e[j] = (s0 + 8 * q + j <= t) ? e[j] : 0.f;
            u32x4 o; o.x = cvt_pk_bf16(e[0], e[1]); o.y = cvt_pk_bf16(e[2], e[3]); o.z = cvt_pk_bf16(e[4], e[5]); o.w = cvt_pk_bf16(e[6], e[7]);
            *(LAS u32x4*)(lds + W_OFF + t * WROW + (s0 + 8 * q) * 2) = o; }
    }
    __syncthreads();
    {
        const int dq = lane & 7, sp = lane >> 3;
        const float* vg = a->in[I_VG] + l * D + 256 * g; const float* vb = a->in[I_VB] + l * D + 256 * g;
#pragma unroll
        for (int i = 0; i < 4; ++i) { const int q = wave * 4 + i, db = q & 3, rb = q >> 2, d0 = 64 * db + 8 * dq, s0 = 16 * rb + 2 * sp;
            const u32x4 xa = *(const u32x4*)(GV + (size_t)(row0 + s0) * D + 256 * g + d0), xb = *(const u32x4*)(GV + (size_t)(row0 + s0 + 1) * D + 256 * g + d0);
            const f32x4 g0 = *(const f32x4*)(vg + d0), g1 = *(const f32x4*)(vg + d0 + 4), c0 = *(const f32x4*)(vb + d0), c1 = *(const f32x4*)(vb + d0 + 4);
            const float ma = st[2 * s0], ra = st[2 * s0 + 1], mb = st[2 * s0 + 2], rb_ = st[2 * s0 + 3];
            const float ea[8] = {bf_lo(xa.x), bf_hi(xa.x), bf_lo(xa.y), bf_hi(xa.y), bf_lo(xa.z), bf_hi(xa.z), bf_lo(xa.w), bf_hi(xa.w)};
            const float eb[8] = {bf_lo(xb.x), bf_hi(xb.x), bf_lo(xb.y), bf_hi(xb.y), bf_lo(xb.z), bf_hi(xb.z), bf_lo(xb.w), bf_hi(xb.w)};
            const float gg[8] = {g0[0], g0[1], g0[2], g0[3], g1[0], g1[1], g1[2], g1[3]}; const float cc[8] = {c0[0], c0[1], c0[2], c0[3], c1[0], c1[1], c1[2], c1[3]};
            const int spi = 8 * rb + sp, c = spi >> 2, wi = spi & 3;
#pragma unroll
            for (int j = 0; j < 8; ++j) { const int d = d0 + j; const float va = (ea[j] - ma) * ra * gg[j] + cc[j], vb2 = (eb[j] - mb) * rb_ * gg[j] + cc[j];
                *(LAS unsigned*)(lds + T_OFF + d * 256 + ((c ^ tsw(d)) << 4) + wi * 4) = cvt_pk_bf16(va, vb2); }
        }
    }
    __syncthreads();
    f32x4 acc[16];
#pragma unroll
    for (int n = 0; n < 16; ++n) acc[n] = (f32x4){0.f, 0.f, 0.f, 0.f};
    const int kmax = (16 * wave + 15) >> 5;
    for (int ks = 0; ks <= kmax; ++ks) {
        const bf16x8 af = *(const LAS bf16x8*)(lds + W_OFF + (16 * wave + fr) * WROW + (32 * ks + 8 * fq) * 2);
#pragma unroll
        for (int n = 0; n < 16; ++n) { const int d = 16 * n + fr; const bf16x8 bfr = *(const LAS bf16x8*)(lds + T_OFF + d * 256 + (((4 * ks + fq) ^ tsw(d)) << 4));
            acc[n] = __builtin_amdgcn_mfma_f32_16x16x32_bf16(bfr, af, acc[n], 0, 0, 0); }
    }
    __syncthreads();
#pragma unroll
    for (int n = 0; n < 16; ++n) *(LAS f32x4*)(lds + Z_OFF + (16 * wave + fr) * ZROW + (16 * n + 4 * fq) * 4) = acc[n];
    __syncthreads();
    {
        const int o8 = (lane & 31) * 8, dcol = 256 * g + o8;
        const float* cw = a->in[I_CW] + (size_t)l * 3 * D + dcol;
        const f32x4 w0a = *(const f32x4*)(cw), w0b = *(const f32x4*)(cw + 4), w1a = *(const f32x4*)(cw + D), w1b = *(const f32x4*)(cw + D + 4), w2a = *(const f32x4*)(cw + 2 * D), w2b = *(const f32x4*)(cw + 2 * D + 4);
        const float w0[8] = {w0a[0], w0a[1], w0a[2], w0a[3], w0b[0], w0b[1], w0b[2], w0b[3]}, w1[8] = {w1a[0], w1a[1], w1a[2], w1a[3], w1b[0], w1b[1], w1b[2], w1b[3]}, w2[8] = {w2a[0], w2a[1], w2a[2], w2a[3], w2b[0], w2b[1], w2b[2], w2b[3]};
#pragma unroll 4
        for (int i = 0; i < 8; ++i) { const int t = 16 * wave + 2 * i + (lane >> 5), r = row0 + t, tseq = r & (SEQ - 1); const size_t off = (size_t)r * D + dcol;
            const u32x4 ug = *(const u32x4*)(UG + off), bs = *(const u32x4*)(BS + off), x0 = *(const u32x4*)(XG + off);
            u32x4 x1 = (u32x4){0u, 0u, 0u, 0u}, x2 = (u32x4){0u, 0u, 0u, 0u};
            if (tseq >= 1) x1 = *(const u32x4*)(XG + off - D);
            if (tseq >= 2) x2 = *(const u32x4*)(XG + off - 2 * D);
            const f32x4 za = *(const LAS f32x4*)(lds + Z_OFF + t * ZROW + o8 * 4), zb = *(const LAS f32x4*)(lds + Z_OFF + t * ZROW + o8 * 4 + 16);
            const float bsp = bspL[t];
            const float z[8] = {za[0], za[1], za[2], za[3], zb[0], zb[1], zb[2], zb[3]};
            const unsigned ugw[4] = {ug.x, ug.y, ug.z, ug.w}, bsw[4] = {bs.x, bs.y, bs.z, bs.w}, x0w[4] = {x0.x, x0.y, x0.z, x0.w}, x1w[4] = {x1.x, x1.y, x1.z, x1.w}, x2w[4] = {x2.x, x2.y, x2.z, x2.w};
            unsigned ow[4];
#pragma unroll
            for (int p = 0; p < 4; ++p) {
                const float m0 = bf_lo(ugw[p]) * (z[2 * p] + bsp) + bf_lo(bsw[p]) * (w0[2 * p] * bf_lo(x2w[p]) + w1[2 * p] * bf_lo(x1w[p]) + w2[2 * p] * bf_lo(x0w[p]));
                const float m1 = bf_hi(ugw[p]) * (z[2 * p + 1] + bsp) + bf_hi(bsw[p]) * (w0[2 * p + 1] * bf_hi(x2w[p]) + w1[2 * p + 1] * bf_hi(x1w[p]) + w2[2 * p + 1] * bf_hi(x0w[p]));
                ow[p] = cvt_pk_bf16(m0, m1); }
            *(u32x4*)(UG + off) = (u32x4){ow[0], ow[1], ow[2], ow[3]}; }
    }
    __syncthreads();
}
__device__ __forceinline__ void mix_sample_item(KArgs a, int l, int item) {
    int tid_ = threadIdx.x; asm volatile("" : "+v"(tid_));
    const int tid = tid_, s = 4 * item + (tid >> 7), d = (tid & 127) * 8, g = d >> 8, r = MPR + s;
    float* stat = (float*)(a->ws + WS_STAT);
    const float* vsum = stat + (size_t)(7 + 2 * l) * MPAD; const float* vsq = vsum + MPAD;
    bf16_t* UG = (bf16_t*)(a->ws + WS_R); const bf16_t* GV = UG + (size_t)MPAD * D; const bf16_t* XG = GV + (size_t)MPAD * D; const bf16_t* BS = XG + (size_t)MPAD * D;
    const float w00 = a->in[I_WSP][(size_t)(l * 4 + g) * 128 * 128], b0 = a->in[I_BSP][(l * 4 + g) * 128];
    const float* cw = a->in[I_CW] + (size_t)l * 3 * D + d;
    const size_t off = (size_t)r * D + d;
    const float mean = vsum[r] * (1.0f / D); const float var = fmaxf(vsq[r] * (1.0f / D) - mean * mean, 0.f); const float rstd = __builtin_amdgcn_rsqf(var + EPS);
    const u32x4 gv = *(const u32x4*)(GV + off), ug = *(const u32x4*)(UG + off), bs = *(const u32x4*)(BS + off), xg = *(const u32x4*)(XG + off);
    const float* st0 = a->in[I_STATE] + ((size_t)(l * NS + s) * 2) * D + d; const float* vgp = a->in[I_VG] + l * D + d; const float* vbp = a->in[I_VB] + l * D + d;
    float* vo = a->out + O_VS + ((size_t)(l * NS + s)) * D + d;
    const unsigned gvw[4] = {gv.x, gv.y, gv.z, gv.w}, ugw[4] = {ug.x, ug.y, ug.z, ug.w}, bsw[4] = {bs.x, bs.y, bs.z, bs.w}, xgw[4] = {xg.x, xg.y, xg.z, xg.w};
    unsigned ow[4];
#pragma unroll
    for (int h = 0; h < 2; ++h) {
        const f32x4 sa = *(const f32x4*)(st0 + 4 * h), sb = *(const f32x4*)(st0 + D + 4 * h), gn = *(const f32x4*)(vgp + 4 * h), bi = *(const f32x4*)(vbp + 4 * h);
        const f32x4 c0 = *(const f32x4*)(cw + 4 * h), c1 = *(const f32x4*)(cw + D + 4 * h), c2 = *(const f32x4*)(cw + 2 * D + 4 * h);
        f32x4 vp;
#pragma unroll
        for (int p = 0; p < 2; ++p) { const int wq = 2 * h + p, j0 = 2 * p;
            const float v0 = (bf_lo(gvw[wq]) - mean) * rstd * gn[j0] + bi[j0], v1 = (bf_hi(gvw[wq]) - mean) * rstd * gn[j0 + 1] + bi[j0 + 1];
            vp[j0] = v0; vp[j0 + 1] = v1;
            const float cv0 = c0[j0] * sa[j0] + c1[j0] * sb[j0] + c2[j0] * bf_lo(xgw[wq]), cv1 = c0[j0 + 1] * sa[j0 + 1] + c1[j0 + 1] * sb[j0 + 1] + c2[j0 + 1] * bf_hi(xgw[wq]);
            ow[wq] = cvt_pk_bf16(bf_lo(ugw[wq]) * (w00 * v0 + b0) + bf_lo(bsw[wq]) * cv0, bf_hi(ugw[wq]) * (w00 * v1 + b0) + bf_hi(bsw[wq]) * cv1); }
        *(f32x4*)(vo + 4 * h) = vp;
    }
    *(u32x4*)(UG + off) = (u32x4){ow[0], ow[1], ow[2], ow[3]};
}

#ifndef PROBE_MASK
#define PROBE_MASK 0
#endif
#ifndef PROBE_AMP
#define PROBE_AMP 4
#endif
#if PROBE_MASK
#define STAMP(i) do { if (blockIdx.x == 0 && threadIdx.x == 0) { volatile LAS unsigned long long* pw_ = (volatile LAS unsigned long long*)(lds + MISC_OFF + 16); \
    const unsigned long long t_ = __builtin_amdgcn_s_memrealtime(); if ((((unsigned)PROBE_MASK) >> (i)) & 1u) pw_[1] += t_ - pw_[0]; pw_[0] = t_; } } while (0)
#else
#define STAMP(i) do { } while (0)
#endif
__global__ void __launch_bounds__(512, 2) fwd_megakernel(Args a_unused) {
    extern __shared__ __attribute__((aligned(16))) unsigned char lds_raw[];
    LAS unsigned char* lds = (LAS unsigned char*)lds_raw;
    cg::grid_group grid = cg::this_grid();
    const int G = gridDim.x, bid = blockIdx.x;

    if (threadIdx.x < 8) ((LAS unsigned*)(lds + MISC_OFF))[threadIdx.x] = 0u;
    __syncthreads();
    { KArgs p = kargs(); if (p->ws == nullptr) grid.sync();
      (void)xcd_barrier_post((unsigned*)(p->ws + WS_BAR), (volatile LAS unsigned*)(lds + MISC_OFF)); }
#define GRID_SYNC() do { XcdBarrier b_; b_.bar = (unsigned*)(kargs()->ws + WS_BAR); b_.x = xb_xcc_id(); b_.st = (volatile LAS unsigned*)(lds + MISC_OFF); xcd_barrier(b_); } while (0)
#if PROBE_MASK
    if (blockIdx.x == 0 && threadIdx.x == 0) { volatile LAS unsigned long long* pw_ = (volatile LAS unsigned long long*)(lds + MISC_OFF + 16); pw_[0] = __builtin_amdgcn_s_memrealtime(); pw_[1] = 0ull; }
#endif
    prologue(kargs(), lds);
    GRID_SYNC(); STAMP(0);
#pragma unroll 1
    for (int l = 0; l < DEPTH; ++l) {
        {
            KArgs p = kargs(); unsigned char* ws = p->ws;
            pg8::Gemm g{(const bf16_t*)(ws + WS_HB), (const bf16_t*)(ws + WS_W) + (size_t)l * LAYER_W_ELEMS + OW1, MPAD, 2 * FF, D}; pg8::StaticOrder S; S.init(MPAD, 2 * FF, G, bid);
            EpiSwiglu E{(bf16_t*)(ws + WS_R), (const float*)(ws + WS_STAT) + (size_t)(3 * l) * MPAD};
            pg8::gemm_phase<EpiSwiglu, true>(lds, g, S, E);
            convert_in_tail(kargs(), l == 0 ? 1 : 3, G, bid);
        }
        GRID_SYNC(); STAMP(1 + 7 * l + 0);
        {
            KArgs p = kargs(); unsigned char* ws = p->ws;
            pg8::Gemm g{(const bf16_t*)(ws + WS_R), (const bf16_t*)(ws + WS_W) + (size_t)l * LAYER_W_ELEMS + OW2, MPAD, D, FF}; pg8::StaticOrder S; S.init(MPR, D, G, bid);
            EpiResid E{l == 0 ? p->in[I_XP] : nullptr, l == 0 ? p->in[I_XS] : nullptr, (bf16_t*)(ws + WS_HB), (float*)(ws + WS_STAT) + (size_t)(3 * l + 1) * MPAD, 0.5f};
            if (!(bid & 1)) for (int it = bid; it < 256; it += G) skinny_resid<22, 11>(lds, g.A, g.Bt, it, E);
            pg8::gemm_phase<EpiResid, true>(lds, g, S, E);
            if (bid & 1) for (int it = bid; it < 256; it += G) skinny_resid<22, 11>(lds, g.A, g.Bt, it, E);
        }
        GRID_SYNC(); STAMP(1 + 7 * l + 1);
        {
            KArgs p = kargs(); unsigned char* ws = p->ws;
            pg8::Gemm g{(const bf16_t*)(ws + WS_HB), (const bf16_t*)(ws + WS_W) + (size_t)l * LAYER_W_ELEMS + OWIN, MPAD, NIN, D}; pg8::StaticOrder S; S.init(MPR, NIN, G, bid);
            EpiMixIn E{(bf16_t*)(ws + WS_R), (const float*)(ws + WS_STAT) + (size_t)(3 * l + 1) * MPAD, p->in[I_BIN] + (size_t)l * NIN, (float*)(ws + WS_STAT) + (size_t)(7 + 2 * l) * MPAD,
                       p->out + O_NCP + (size_t)l * NB * 2 * D, l};
            for (int it = bid; it < 256; it += G) skinny_mixin(g.A, g.Bt, it, E);
            pg8::gemm_phase<EpiMixIn, true>(lds, g, S, E);
        }
        GRID_SYNC(); STAMP(1 + 7 * l + 2);
        {
            KArgs p = kargs();
            for (int it = bid; it < 544; it += G) {
                if (it < 512) mix_prompt_item(p, lds, l, it >> 2, it & 3); else mix_sample_item(p, l, it - 512);
            }
        }
        GRID_SYNC(); STAMP(1 + 7 * l + 3);
        {
            KArgs p = kargs(); unsigned char* ws = p->ws;
            pg8::Gemm g{(const bf16_t*)(ws + WS_R), (const bf16_t*)(ws + WS_W) + (size_t)l * LAYER_W_ELEMS + OWO, MPAD, D, D}; pg8::StaticOrder S; S.init(MPR, D, G, bid);
            EpiResid E{nullptr, nullptr, (bf16_t*)(ws + WS_HB), (float*)(ws + WS_STAT) + (size_t)(3 * l + 2) * MPAD, 1.0f};
            if (!(bid & 1)) for (int it = bid; it < 256; it += G) skinny_resid<8, 8>(lds, g.A, g.Bt, it, E);
            pg8::gemm_phase<EpiResid, true>(lds, g, S, E);
            if (bid & 1) for (int it = bid; it < 256; it += G) skinny_resid<8, 8>(lds, g.A, g.Bt, it, E);
        }
        GRID_SYNC(); STAMP(1 + 7 * l + 4);
        {
            KArgs p = kargs(); unsigned char* ws = p->ws;
            pg8::Gemm g{(const bf16_t*)(ws + WS_HB), (const bf16_t*)(ws + WS_W) + (size_t)l * LAYER_W_ELEMS + OW6, MPAD, 2 * FF, D}; pg8::StaticOrder S; S.init(MPAD, 2 * FF, G, bid);
            EpiSwiglu E{(bf16_t*)(ws + WS_R), (const float*)(ws + WS_STAT) + (size_t)(3 * l + 2) * MPAD};
            pg8::gemm_phase<EpiSwiglu, true>(lds, g, S, E);
            convert_in_tail(kargs(), l == 0 ? 2 : 4, G, bid);
        }
        GRID_SYNC(); STAMP(1 + 7 * l + 5);
        {
            KArgs p = kargs(); unsigned char* ws = p->ws;
            pg8::Gemm g{(const bf16_t*)(ws + WS_R), (const bf16_t*)(ws + WS_W) + (size_t)l * LAYER_W_ELEMS + OW7, MPAD, D, FF}; pg8::StaticOrder S; S.init(MPR, D, G, bid);
            EpiResid E{nullptr, nullptr, (bf16_t*)(ws + WS_HB), (float*)(ws + WS_STAT) + (size_t)(3 * l + 3) * MPAD, 0.5f};
            if (!(bid & 1)) for (int it = bid; it < 256; it += G) skinny_resid<22, 11>(lds, g.A, g.Bt, it, E);
            pg8::gemm_phase<EpiResid, true>(lds, g, S, E);
            if (bid & 1) for (int it = bid; it < 256; it += G) skinny_resid<22, 11>(lds, g.A, g.Bt, it, E);
        }
        GRID_SYNC(); STAMP(1 + 7 * l + 6);
    }
    {
        KArgs p = kargs();
        int tid_ = threadIdx.x; asm volatile("" : "+v"(tid_));
        const int tid = tid_, lane = tid & 63, wave = tid >> 6;
        const float* rsf = (const float*)(p->ws + WS_STAT) + (size_t)6 * MPAD;
        const f32x4* fn4 = (const f32x4*)p->in[I_FN] + lane;
        float* Y = p->out; const bf16_t* HBf = (const bf16_t*)(p->ws + WS_HB);
        for (int r = bid * 8 + wave; r < M; r += G * 8) {
            const float rs = __builtin_amdgcn_rsqf(rsf[r] * (1.0f / D) + EPS);
            f32x4* y = (f32x4*)(Y + (size_t)r * D) + lane;
            const u32x2* hrow = (const u32x2*)(HBf + (size_t)r * D) + lane;
#pragma unroll
            for (int j = 0; j < 4; ++j) { const u32x2 hw = hrow[64 * j]; y[64 * j] = (f32x4){bf_lo(hw.x), bf_hi(hw.x), bf_lo(hw.y), bf_hi(hw.y)} * rs * fn4[64 * j]; }
        }
    }
#if PROBE_MASK
    STAMP(15);
    if (blockIdx.x == 0 && threadIdx.x == 0) { volatile LAS unsigned long long* pw_ = (volatile LAS unsigned long long*)(lds + MISC_OFF + 16); const unsigned long long t0_ = pw_[0], tg_ = pw_[1] * PROBE_AMP;
        while (__builtin_amdgcn_s_memrealtime() - t0_ < tg_) __builtin_amdgcn_s_sleep(20); }
#endif
}

extern "C" void kernel_launch(void* const* d_in, const int* in_sizes, int n_in, void* d_out, int out_size, void* d_ws, size_t ws_size, hipStream_t stream) {
    static int grid = 0;
    if (grid == 0) {
        if (n_in != 21 || ws_size < WS_END) { fprintf(stderr, "kernel_launch: bad setup n_in %d ws %zu (need %zu)\n", n_in, ws_size, (size_t)WS_END); grid = -1; return; }
        int dev = 0, cus = 0, per_cu = 0;
        (void)hipGetDevice(&dev);
        (void)hipDeviceGetAttribute(&cus, hipDeviceAttributeMultiprocessorCount, dev);
        (void)hipFuncSetAttribute((const void*)fwd_megakernel, hipFuncAttributeMaxDynamicSharedMemorySize, LDS_BYTES);
        (void)hipOccupancyMaxActiveBlocksPerMultiprocessor(&per_cu, (const void*)fwd_megakernel, 512, LDS_BYTES);
        if (per_cu < 1) per_cu = 1;
        grid = cus * per_cu;
        (void)hipGetLastError();
    }
    if (grid < 0) return;
    if (hipMemsetAsync((char*)d_ws + WS_BAR, 0, BAR_BYTES, stream) != hipSuccess) { fprintf(stderr, "memset failed\n"); return; }
    Args a{};
    for (int i = 0; i < 21; ++i) a.in[i] = (const float*)d_in[i];
    a.out = (float*)d_out; a.ws = (unsigned char*)d_ws;
    void* args[] = {&a};
    hipError_t e = hipLaunchCooperativeKernel((const void*)fwd_megakernel, dim3(grid), dim3(512), args, LDS_BYTES, stream);
    if (e != hipSuccess) fprintf(stderr, "cooperative launch failed: %s (grid %d)\n", hipGetErrorString(e), grid);
}
```

```cpp
#include <hip/hip_runtime.h>
#include <hip/hip_cooperative_groups.h>
#include <cstdio>
#include <cstdint>
namespace cg = cooperative_groups;

#define LAS __attribute__((address_space(3)))
typedef unsigned short bf16_t;
typedef short bf16x8 __attribute__((ext_vector_type(8)));
typedef float f32x4 __attribute__((ext_vector_type(4)));
typedef float f32x2 __attribute__((ext_vector_type(2)));
typedef unsigned u32x4 __attribute__((ext_vector_type(4)));
typedef unsigned u32x2 __attribute__((ext_vector_type(2)));

constexpr int D = 1024, FF = 2816, NIN = 7168, SEQ = 2048, NB = 8, NS = 128, DEPTH = 2;
constexpr int MPR = NB * SEQ;
constexpr int M = MPR + NS;
constexpr int MPAD = 16640;
constexpr float EPS = 1e-6f;
constexpr size_t O_Y = 0, O_NCP = (size_t)M * D, O_NCS = O_NCP + (size_t)DEPTH * NB * 2 * D, O_VS = O_NCS + (size_t)DEPTH * NS * 2 * D;
constexpr size_t MiB = 1u << 20;
constexpr size_t WS_STAT = 0;
constexpr size_t WS_BAR = 768 * 1024, BAR_BYTES = 16384;
constexpr size_t WS_W = 1 * MiB;
constexpr size_t LAYER_W_ELEMS = 25690112;
constexpr size_t OW1 = 0, OW2 = 5767168, OWIN = 8650752, OWO = 15990784, OW6 = 17039360, OW7 = 22806528;
constexpr size_t WS_HB = 99 * MiB;
constexpr size_t ACT_BYTES = (size_t)MPAD * D * 2;
constexpr size_t WS_R = WS_HB + ACT_BYTES;
constexpr size_t WS_END = WS_R + 4 * ACT_BYTES;
constexpr int LDS_BYTES = 147456;

__device__ __forceinline__ unsigned cvt_pk_bf16(float lo, float hi) { unsigned r; asm("v_cvt_pk_bf16_f32 %0, %1, %2" : "=v"(r) : "v"(lo), "v"(hi)); return r; }
__device__ __forceinline__ float bf_lo(unsigned w) { return __uint_as_float(w << 16); }
__device__ __forceinline__ float bf_hi(unsigned w) { return __uint_as_float(w & 0xffff0000u); }
__device__ __forceinline__ float sigmoidf_(float x) { return __builtin_amdgcn_rcpf(1.0f + __builtin_amdgcn_exp2f(-1.44269504089f * x)); }
__device__ __forceinline__ float siluf_(float x) { return x * sigmoidf_(x); }
__device__ __forceinline__ f32x2 gelu_pk(f32x2 v) {
    const f32x2 av = __builtin_elementwise_abs(v), d = av * 0.2316418882f + 1.0f;
    f32x2 t; t.x = __builtin_amdgcn_rcpf(d.x); t.y = __builtin_amdgcn_rcpf(d.y);
    f32x2 q = t * 0.5307027145f + (-0.7265760135f); q = q * t + 0.7107068705f; q = q * t + (-0.142248368f); q = q * t + 0.127414796f; q = q * t;
    const f32x2 s = (v * v) * (-0.72134752044f);
    f32x2 e; e.x = __builtin_amdgcn_exp2f(s.x); e.y = __builtin_amdgcn_exp2f(s.y);
    const f32x2 m = v * (q * e), r = v - m;
    f32x2 o; o.x = v.x < 0.f ? m.x : r.x; o.y = v.y < 0.f ? m.y : r.y; return o;
}
__device__ __forceinline__ f32x4 gelu4(f32x4 v) { f32x2 a = gelu_pk((f32x2){v[0], v[1]}), b = gelu_pk((f32x2){v[2], v[3]}); return (f32x4){a.x, a.y, b.x, b.y}; }
__device__ __forceinline__ float wave_sum(float v) {
#pragma unroll
    for (int o = 1; o < 64; o <<= 1) v += __shfl_xor(v, o);
    return v;
}

namespace pg8 {
constexpr int BM = 256, BK = 64, HALF = 128, HTB = HALF * BK * 2, STAGE_BYTES = 8 * HTB, NXCD = 8, WGM = 8;
constexpr int PRE_OFF = STAGE_BYTES, PRE_SLOT = 2048;
__host__ __device__ __forceinline__ int lds_byte(int r, int c) { const int st = (r >> 4) * 2 + (c >> 5), rr = r & 15, cc = c & 31, ob = rr * 64 + cc * 2; return st * 1024 + (ob ^ (((ob >> 9) & 1) << 5)); }
__host__ __device__ __forceinline__ void stage_rc(int b, int& R, int& C) { const int st = b / 1024, sb = b % 1024, swz = sb ^ (((sb >> 9) & 1) << 5); R = (st >> 1) * 16 + swz / 64; C = (st & 1) * 32 + (swz % 64) / 2; }
__host__ __device__ __forceinline__ int perm32(int rho) { const int n = rho >> 4, i = rho & 15; return 8 * (i >> 2) + 4 * n + (i & 3); }
struct Unit { int pm, pn; };
struct Gemm { const bf16_t* A; const bf16_t* Bt; int M, N, K; };
struct StaticOrder {
    int nM, nN, nwg, G, c;
    __device__ void init(int M_, int N_, int G_, int c_) { nM = M_ / BM; nN = N_ / BM; nwg = nM * nN; G = G_; c = c_; }
    __device__ bool next(int i, Unit& u) const {
        const long L = (long)i * G + c; if (L >= nwg) return false;
        int wgid = (int)L; { const int q = nwg / NXCD, r = nwg % NXCD, xcd = wgid % NXCD, off = wgid / NXCD; wgid = (xcd < r ? xcd * (q + 1) : r * (q + 1) + (xcd - r) * q) + off; }
        const int nig = WGM * nN, gid = wgid / nig, fm = gid * WGM, gsz = (nM - fm) < WGM ? (nM - fm) : WGM;
        u.pm = fm + ((wgid % nig) % gsz); u.pn = (wgid % nig) / gsz; return true;
    }
};

template <class Epi, bool ALIGN_EPI>
__device__ __forceinline__ void gemm_phase(LAS unsigned char* lds, const Gemm g, const StaticOrder& S, const Epi& E) {
    int tid_ = threadIdx.x; asm volatile("" : "+v"(tid_));
    const int tid = tid_, wid = __builtin_amdgcn_readfirstlane(tid >> 6), lane = tid & 63, wr = wid >> 2, wc = wid & 3, fr = lane & 15, fq = lane >> 4;
    const int K = g.K, nt = K / BK;
    unsigned voffA[2], voffB[2];
#pragma unroll
    for (int i = 0; i < 2; ++i) { int R, C; stage_rc(tid * 16 + i * 8192, R, C); const int Rb = Epi::PERM ? ((R & ~31) + perm32(R & 31)) : R;
        voffA[i] = (unsigned)(R * K + C) * 2u; voffB[i] = (unsigned)(Rb * K + C) * 2u; }
    const size_t kstep = (size_t)(BK * 2);
    const size_t hstep = (size_t)HALF * K * 2;
    const size_t tstep = 2 * hstep;
    const unsigned ldsw = (unsigned)wid * 1024u;
    const int aoff = lds_byte(wr * 64 + fr, fq * 8), boff = lds_byte(wc * 32 + fr, fq * 8);
#define PG8_SA(b, h) (((b) * 2 + (h)) * HTB)
#define PG8_SB(b, h) ((4 + (b) * 2 + (h)) * HTB)
#define PG8_STAGE(bufoff, gbase, voff) do { _Pragma("unroll") for (int _i = 0; _i < 2; ++_i) \
        __builtin_amdgcn_global_load_lds((const unsigned*)((const char*)(gbase) + (voff)[_i]), (LAS unsigned*)(lds + (bufoff) + ldsw + _i * 8192), 16, 0, 0); } while (0)
#define PG8_LDA(dst, b, h) do { _Pragma("unroll") for (int m = 0; m < 4; ++m) _Pragma("unroll") for (int k = 0; k < 2; ++k) dst[m][k] = *(const LAS bf16x8*)(lds + PG8_SA(b, h) + aoff + m * 2048 + k * 1024); } while (0)
#define PG8_LDB(dst, b, h) do { _Pragma("unroll") for (int n = 0; n < 2; ++n) _Pragma("unroll") for (int k = 0; k < 2; ++k) dst[n][k] = *(const LAS bf16x8*)(lds + PG8_SB(b, h) + boff + n * 2048 + k * 1024); } while (0)
#define PG8_MMA(ai, bj, At, Bt) do { __builtin_amdgcn_s_setprio(1); _Pragma("unroll") for (int m = 0; m < 4; ++m) _Pragma("unroll") for (int n = 0; n < 2; ++n) _Pragma("unroll") for (int k = 0; k < 2; ++k) \
        acc[ai][bj][m][n] = __builtin_amdgcn_mfma_f32_16x16x32_bf16(Bt[n][k], At[m][k], acc[ai][bj][m][n], 0, 0, 0); __builtin_amdgcn_s_setprio(0); } while (0)
#define PG8_WAIT_V(n) asm volatile("s_waitcnt vmcnt(" #n ")" ::: "memory")
#define PG8_WAIT_L(n) asm volatile("s_waitcnt lgkmcnt(" #n ")" ::: "memory")
#define PG8_BAR __builtin_amdgcn_s_barrier()
#define PG8_SCHED __builtin_amdgcn_sched_barrier(0)
    Unit cur, nxt; int ui = 0;
    if (!S.next(0, cur)) return;
    f32x4 acc[2][2][4][2];
#pragma unroll
    for (int a = 0; a < 2; ++a)
#pragma unroll
        for (int b = 0; b < 2; ++b)
#pragma unroll
            for (int m = 0; m < 4; ++m)
#pragma unroll
                for (int n = 0; n < 2; ++n) acc[a][b][m][n] = (f32x4){0.f, 0.f, 0.f, 0.f};
    bf16x8 At[4][2], B0[2][2], B1[2][2];
    const char* cA = (const char*)g.A + (size_t)cur.pm * tstep; const char* cB = (const char*)g.Bt + (size_t)cur.pn * tstep;
    if constexpr (Epi::PRE) E.pre(cur, lds + PRE_OFF, wid, lane);
    PG8_STAGE(PG8_SB(0, 0), cB, voffB); PG8_STAGE(PG8_SB(0, 1), cB + hstep, voffB); PG8_STAGE(PG8_SA(0, 0), cA, voffA); PG8_STAGE(PG8_SA(0, 1), cA + hstep, voffA);
    if (wr == 1) PG8_BAR;
    PG8_WAIT_V(2); PG8_BAR;
    PG8_STAGE(PG8_SB(1, 0), cB + kstep, voffB); PG8_STAGE(PG8_SA(1, 0), cA + kstep, voffA); PG8_STAGE(PG8_SB(1, 1), cB + hstep + kstep, voffB);
    PG8_WAIT_V(6); PG8_BAR;
    for (;;) {
        const bool has_next = S.next(ui + 1, nxt);
        const char* nA = has_next ? (const char*)g.A + (size_t)nxt.pm * tstep : cA; const char* nB = has_next ? (const char*)g.Bt + (size_t)nxt.pn * tstep : cB;
        for (int t = 0; t < nt; t += 2) {
            const bool last = (t == nt - 2);
            const char* a1 = cA + (size_t)(t + 1) * kstep;
            const char* a2 = last ? nA : cA + (size_t)(t + 2) * kstep; const char* b2 = last ? nB : cB + (size_t)(t + 2) * kstep;
            const char* a3 = a2 + kstep; const char* b3 = b2 + kstep;
            PG8_LDB(B0, 0, 0); PG8_LDB(B1, 0, 1); PG8_SCHED; PG8_LDA(At, 0, 0); PG8_STAGE(PG8_SA(1, 1), a1 + hstep, voffA);
            PG8_WAIT_V(8); PG8_WAIT_L(0); PG8_BAR; PG8_MMA(0, 0, At, B0); PG8_MMA(0, 1, At, B1); PG8_BAR; PG8_SCHED;
            PG8_LDA(At, 0, 1); PG8_STAGE(PG8_SB(0, 0), b2, voffB); PG8_STAGE(PG8_SB(0, 1), b2 + hstep, voffB); PG8_STAGE(PG8_SA(0, 0), a2, voffA);
            PG8_WAIT_V(8); PG8_WAIT_L(0); PG8_BAR; PG8_MMA(1, 0, At, B0); PG8_MMA(1, 1, At, B1); PG8_BAR; PG8_SCHED;
            PG8_LDB(B0, 1, 0); PG8_LDB(B1, 1, 1); PG8_SCHED; PG8_LDA(At, 1, 0); PG8_STAGE(PG8_SA(0, 1), a2 + hstep, voffA);
            PG8_WAIT_V(8); PG8_WAIT_L(0); PG8_BAR; PG8_MMA(0, 0, At, B0); PG8_MMA(0, 1, At, B1); PG8_BAR; PG8_SCHED;
            PG8_LDA(At, 1, 1); PG8_STAGE(PG8_SB(1, 0), b3, voffB); PG8_STAGE(PG8_SB(1, 1), b3 + hstep, voffB); PG8_STAGE(PG8_SA(1, 0), a3, voffA);
            PG8_WAIT_V(8); PG8_WAIT_L(0); PG8_BAR; PG8_MMA(1, 0, At, B0); PG8_MMA(1, 1, At, B1); PG8_BAR; PG8_SCHED;
        }
        if constexpr (ALIGN_EPI) { if (wr == 0) PG8_BAR; }
        if constexpr (Epi::PRE) E(acc, cur, wr, wc, fr, fq, lds + PRE_OFF + (ui & 1) * PRE_SLOT);
        else if constexpr (Epi::RED) E(acc, cur, wr, wc, fr, fq, lds + PRE_OFF);
        else E(acc, cur, wr, wc, fr, fq);
        if (!has_next) break;
#pragma unroll
        for (int a = 0; a < 2; ++a)
#pragma unroll
            for (int b = 0; b < 2; ++b)
#pragma unroll
                for (int m = 0; m < 4; ++m)
#pragma unroll
                    for (int n = 0; n < 2; ++n) acc[a][b][m][n] = (f32x4){0.f, 0.f, 0.f, 0.f};
        cur = nxt; cA = nA; cB = nB; ++ui;
        if constexpr (Epi::PRE) E.pre(cur, lds + PRE_OFF + (ui & 1) * PRE_SLOT, wid, lane);
        if constexpr (ALIGN_EPI) { if (wr == 1) PG8_BAR; }
    }
    PG8_WAIT_V(0);
    if constexpr (!ALIGN_EPI) { if (wr == 0) PG8_BAR; }
    PG8_BAR;
#undef PG8_SA
#undef PG8_SB
#undef PG8_STAGE
#undef PG8_LDA
#undef PG8_LDB
#undef PG8_MMA
#undef PG8_WAIT_V
#undef PG8_WAIT_L
#undef PG8_BAR
#undef PG8_SCHED
}
}

constexpr int LAST_PM = MPR / 256;

struct EpiSwiglu {
    static constexpr bool PERM = true, PRE = true, RED = false;
    bf16_t* H; const float* rowss;
    __device__ __forceinline__ void pre(const pg8::Unit& u, LAS unsigned char* slot, int wid, int lane) const {
        if (wid < 4) __builtin_amdgcn_global_load_lds((const unsigned*)(rowss + u.pm * 256 + wid * 64 + lane), (LAS unsigned*)(slot + wid * 256), 4, 0, 0);
    }
    __device__ __forceinline__ void operator()(const f32x4 (&acc)[2][2][4][2], const pg8::Unit& u, int wr, int wc, int fr, int fq, LAS unsigned char* slot) const {
        const LAS float* rsl = (const LAS float*)slot;
        const int row0 = u.pm * 256 + wr * 64 + fr, col0 = u.pn * 128 + wc * 32 + 8 * fq;
        const int nai = (u.pm == LAST_PM) ? 1 : 2;
#pragma unroll
        for (int ai = 0; ai < 2; ++ai) { if (ai < nai) {
#pragma unroll
            for (int m = 0; m < 4; ++m) {
                const int r = row0 + ai * 128 + m * 16;
                const float rs = __builtin_amdgcn_rsqf(rsl[ai * 128 + wr * 64 + m * 16 + fr] * (1.0f / D) + EPS);
                float h[8];
#pragma unroll
                for (int n = 0; n < 2; ++n) {
                    const f32x4 gq = acc[ai][0][m][n] * rs, uq = acc[ai][1][m][n] * rs, tq = gq * (-1.44269504089f);
                    f32x4 eq; eq[0] = __builtin_amdgcn_exp2f(tq[0]); eq[1] = __builtin_amdgcn_exp2f(tq[1]); eq[2] = __builtin_amdgcn_exp2f(tq[2]); eq[3] = __builtin_amdgcn_exp2f(tq[3]);
                    const f32x4 dq = eq + 1.0f;
                    f32x4 rq; rq[0] = __builtin_amdgcn_rcpf(dq[0]); rq[1] = __builtin_amdgcn_rcpf(dq[1]); rq[2] = __builtin_amdgcn_rcpf(dq[2]); rq[3] = __builtin_amdgcn_rcpf(dq[3]);
                    const f32x4 hq = (gq * uq) * rq;
                    h[n * 4 + 0] = hq[0]; h[n * 4 + 1] = hq[1]; h[n * 4 + 2] = hq[2]; h[n * 4 + 3] = hq[3];
                }
                u32x4 w; w.x = cvt_pk_bf16(h[0], h[1]); w.y = cvt_pk_bf16(h[2], h[3]); w.z = cvt_pk_bf16(h[4], h[5]); w.w = cvt_pk_bf16(h[6], h[7]);
                *(u32x4*)(H + (size_t)r * FF + col0) = w;
            }
        } }
    }
};

struct EpiResid {
    static constexpr bool PERM = true, PRE = false, RED = true;
    const float* xP; const float* xS; bf16_t* HB; float* rowss_next; float scale;
    __device__ __forceinline__ void operator()(const f32x4 (&acc)[2][2][4][2], const pg8::Unit& u, int wr, int wc, int fr, int fq, LAS unsigned char* red) const {
        LAS float* part = (LAS float*)red;
        const int row0 = u.pm * 256 + wr * 64 + fr, col0 = u.pn * 256 + wc * 32 + 8 * fq;
        const int nai = (u.pm == LAST_PM) ? 1 : 2;
#pragma unroll
        for (int ai = 0; ai < 2; ++ai) { if (ai < nai) {
#pragma unroll
            for (int m = 0; m < 4; ++m) {
                const int r = row0 + ai * 128 + m * 16;
                float ss = 0.f;
#pragma unroll
                for (int bj = 0; bj < 2; ++bj) {
                    const int c = col0 + bj * 128;
                    f32x4 b0, b1;
                    if (xP) { const float* b = (r < MPR) ? xP + (size_t)r * D : xS + (size_t)(r - MPR) * D; b0 = *(const f32x4*)(b + c); b1 = *(const f32x4*)(b + c + 4); }
                    else { const u32x4 hw = *(const u32x4*)(HB + (size_t)r * D + c); b0 = (f32x4){bf_lo(hw.x), bf_hi(hw.x), bf_lo(hw.y), bf_hi(hw.y)}; b1 = (f32x4){bf_lo(hw.z), bf_hi(hw.z), bf_lo(hw.w), bf_hi(hw.w)}; }
                    const f32x4 o0 = b0 + acc[ai][bj][m][0] * scale, o1 = b1 + acc[ai][bj][m][1] * scale;
                    ss += (o0[0] * o0[0] + o0[1] * o0[1]) + (o0[2] * o0[2] + o0[3] * o0[3]) + (o1[0] * o1[0] + o1[1] * o1[1]) + (o1[2] * o1[2] + o1[3] * o1[3]);
                    u32x4 w; w.x = cvt_pk_bf16(o0[0], o0[1]); w.y = cvt_pk_bf16(o0[2], o0[3]); w.z = cvt_pk_bf16(o1[0], o1[1]); w.w = cvt_pk_bf16(o1[2], o1[3]);
                    *(u32x4*)(HB + (size_t)r * D + c) = w;
                }
                ss += __shfl_xor(ss, 16); ss += __shfl_xor(ss, 32);
                if (fq == 0) part[wc * 256 + ai * 128 + wr * 64 + m * 16 + fr] = ss;
            }
        } }
        asm volatile("s_waitcnt lgkmcnt(0)" ::: "memory"); __builtin_amdgcn_s_barrier(); asm volatile("" ::: "memory");
        { const int tid = (wr * 4 + wc) * 64 + fq * 16 + fr;
          if (tid < 128 * nai) { const float t = (part[tid] + part[256 + tid]) + (part[512 + tid] + part[768 + tid]); atomicAdd(rowss_next + u.pm * 256 + tid, t); } }
    }
};

struct EpiMixIn {
    static constexpr bool PERM = true, PRE = true, RED = false;
    bf16_t* UG; const float* rowss; const float* bin; float* vsum; float* ncp; int l;
    __device__ __forceinline__ void pre(const pg8::Unit& u, LAS unsigned char* slot, int wid, int lane) const {
        if (wid < 4) __builtin_amdgcn_global_load_lds((const unsigned*)(rowss + u.pm * 256 + wid * 64 + lane), (LAS unsigned*)(slot + wid * 256), 4, 0, 0);
        else { const int type = u.pn >> 3, c = (wid - 4) * 64 + lane;
            int src;
            if (type < 3) { const int o0 = type == 0 ? 0 : (type == 1 ? 3072 : 2048), o1 = type == 0 ? 5120 : (type == 1 ? 4096 : 6144); src = (c < 128 ? o0 : o1) + (u.pn & 7) * 128 + (c & 127); }
            else src = 1024 + (u.pn - 24) * 256 + c;
            __builtin_amdgcn_global_load_lds((const unsigned*)(bin + src), (LAS unsigned*)(slot + 1024 + (wid - 4) * 256), 4, 0, 0); }
    }
    __device__ __forceinline__ void operator()(const f32x4 (&acc)[2][2][4][2], const pg8::Unit& u, int wr, int wc, int fr, int fq, LAS unsigned char* slot) const {
        const LAS float* rsl = (const LAS float*)slot; const LAS float* bl = (const LAS float*)(slot + 1024);
        const int row0 = u.pm * 256 + wr * 64 + fr;
        const int nai = (u.pm == LAST_PM) ? 1 : 2;
        const int type = u.pn >> 3;
        bf16_t* const GV = UG + (size_t)MPAD * D; bf16_t* const XG = GV + (size_t)MPAD * D; bf16_t* const BS = XG + (size_t)MPAD * D;
        float* const vsq = vsum + MPAD; float* const ncs = ncp + (O_NCS - O_NCP) + (size_t)l * (NS - NB) * 2 * D;
        if (type < 3) {
            const int col0 = (u.pn & 7) * 128 + wc * 32 + 8 * fq;
            const int o0 = type == 0 ? 0 : (type == 1 ? 3072 : 2048), o1 = type == 0 ? 5120 : (type == 1 ? 4096 : 6144);
            bf16_t* O = type == 0 ? UG : (type == 1 ? XG : BS);
            const int cb = wc * 32 + 8 * fq;
            const f32x4 b00 = *(const LAS f32x4*)(bl + cb), b01 = *(const LAS f32x4*)(bl + cb + 4);
            const f32x4 b10 = *(const LAS f32x4*)(bl + 128 + cb), b11 = *(const LAS f32x4*)(bl + 128 + cb + 4);
#pragma unroll
            for (int ai = 0; ai < 2; ++ai) { if (ai < nai) {
#pragma unroll
                for (int m = 0; m < 4; ++m) {
                    const int r = row0 + ai * 128 + m * 16;
                    const float rs = __builtin_amdgcn_rsqf(rsl[ai * 128 + wr * 64 + m * 16 + fr] * (1.0f / D) + EPS);
                    f32x4 p0 = acc[ai][0][m][0] * rs + b00, p1 = acc[ai][0][m][1] * rs + b01;
                    f32x4 q0 = acc[ai][1][m][0] * rs + b10, q1 = acc[ai][1][m][1] * rs + b11;
                    f32x4 r0, r1;
                    if (type == 0) { p0 = gelu4(p0); p1 = gelu4(p1);
#pragma unroll
                        for (int j = 0; j < 4; ++j) { r0[j] = p0[j] * sigmoidf_(q0[j]); r1[j] = p1[j] * sigmoidf_(q1[j]); } }
                    else if (type == 1) { r0 = p0 * q0; r1 = p1 * q1;
                        if (r < MPR) { const int t = r & (SEQ - 1); if (t >= SEQ - 2) { float* o = ncp + ((size_t)((r >> 11) * 2 + (t - (SEQ - 2)))) * D + col0; *(f32x4*)o = r0; *(f32x4*)(o + 4) = r1; } }
                        else { float* o = ncs + ((size_t)((r - MPR) * 2 + 1)) * D + col0; *(f32x4*)o = r0; *(f32x4*)(o + 4) = r1; } }
                    else {
#pragma unroll
                        for (int j = 0; j < 4; ++j) { r0[j] = p0[j] * sigmoidf_(q0[j]); r1[j] = p1[j] * sigmoidf_(q1[j]); } }
                    u32x4 w; w.x = cvt_pk_bf16(r0[0], r0[1]); w.y = cvt_pk_bf16(r0[2], r0[3]); w.z = cvt_pk_bf16(r1[0], r1[1]); w.w = cvt_pk_bf16(r1[2], r1[3]);
                    *(u32x4*)(O + (size_t)r * D + col0) = w;
                }
            } }
        } else {
            const int col0 = (u.pn - 24) * 256 + wc * 32 + 8 * fq;
            f32x4 bv[2][2];
#pragma unroll
            for (int bj = 0; bj < 2; ++bj)
#pragma unroll
                for (int n = 0; n < 2; ++n) bv[bj][n] = *(const LAS f32x4*)(bl + bj * 128 + wc * 32 + 8 * fq + 4 * n);
#pragma unroll
            for (int ai = 0; ai < 2; ++ai) { if (ai < nai) {
#pragma unroll
                for (int m = 0; m < 4; ++m) {
                    const int r = row0 + ai * 128 + m * 16;
                    const float rs = __builtin_amdgcn_rsqf(rsl[ai * 128 + wr * 64 + m * 16 + fr] * (1.0f / D) + EPS);
                    float s1 = 0.f, s2 = 0.f;
#pragma unroll
                    for (int bj = 0; bj < 2; ++bj) {
                        f32x4 v0 = gelu4(acc[ai][bj][m][0] * rs + bv[bj][0]), v1 = gelu4(acc[ai][bj][m][1] * rs + bv[bj][1]);
                        s1 += (v0[0] + v0[1]) + (v0[2] + v0[3]) + (v1[0] + v1[1]) + (v1[2] + v1[3]);
                        s2 += (v0[0] * v0[0] + v0[1] * v0[1]) + (v0[2] * v0[2] + v0[3] * v0[3]) + (v1[0] * v1[0] + v1[1] * v1[1]) + (v1[2] * v1[2] + v1[3] * v1[3]);
                        u32x4 w; w.x = cvt_pk_bf16(v0[0], v0[1]); w.y = cvt_pk_bf16(v0[2], v0[3]); w.z = cvt_pk_bf16(v1[0], v1[1]); w.w = cvt_pk_bf16(v1[2], v1[3]);
                        *(u32x4*)(GV + (size_t)r * D + col0 + bj * 128) = w;
                    }
                    s1 += __shfl_xor(s1, 16); s1 += __shfl_xor(s1, 32); s2 += __shfl_xor(s2, 16); s2 += __shfl_xor(s2, 32);
                    if (fq == 0) { atomicAdd(vsum + r, s1); atomicAdd(vsq + r, s2); }
                }
            } }
        }
    }
};


#define XB_TMO      128
#define XB_XCNT(j)  (256  + 64 * (j))
#define XB_XSUB(j)  (1280 + 64 * (j))
#define XB_XGEN(j)  (2304 + 64 * (j))
#define XB_TOP      3328
#define XB_TOPGEN   3392
#define XCD_BAR_WORDS 3456
#define XB_SPIN_CAP (1u << 18)
__device__ __forceinline__ unsigned xb_ld(unsigned* p)              { return __hip_atomic_load(p, __ATOMIC_RELAXED, __HIP_MEMORY_SCOPE_AGENT); }
__device__ __forceinline__ unsigned xb_add(unsigned* p, unsigned v) { return __hip_atomic_fetch_add(p, v, __ATOMIC_RELAXED, __HIP_MEMORY_SCOPE_AGENT); }
__device__ __forceinline__ unsigned xb_xcc_id() { return (unsigned)__builtin_amdgcn_s_getreg((3 << 11) | 20) & 0xFu; }
#define XB_SPIN(cond, bar) do { unsigned _sp = 0; while (cond) { __builtin_amdgcn_s_sleep(1); \
    if ((++_sp & 255u) == 0u) { if (xb_ld(&(bar)[XB_TMO])) break; if (_sp > XB_SPIN_CAP) { atomicAdd(&(bar)[XB_TMO], 1u); break; } } } } while (0)
struct XcdBarrier { unsigned* bar; unsigned x; volatile LAS unsigned* st; };
__device__ __forceinline__ XcdBarrier xcd_barrier_post(unsigned* bar, volatile LAS unsigned* st) {
    XcdBarrier b; b.bar = bar; b.x = xb_xcc_id(); b.st = st;
    if (threadIdx.x == 0) (void)xb_add(&bar[XB_XCNT(b.x)], 1u);
    return b;
}
__device__ __forceinline__ void xcd_barrier_complete(unsigned* bar, unsigned x, unsigned& nloc, unsigned& nx) {
    const unsigned G = gridDim.x * gridDim.y * gridDim.z;
    unsigned sum, cnt, mine, sp = 0u;
    for (;;) {
        sum = 0u; cnt = 0u; mine = 0u;
#pragma unroll
        for (unsigned j = 0; j < 16; ++j) { const unsigned c = xb_ld(&bar[XB_XCNT(j)]); sum += c; cnt += (c > 0u) ? 1u : 0u; mine = (j == x) ? c : mine; }
        if (sum == G) break;
        __builtin_amdgcn_s_sleep(1);
        if ((++sp & 255u) == 0u) { if (xb_ld(&bar[XB_TMO])) break; if (sp > XB_SPIN_CAP) { atomicAdd(&bar[XB_TMO], 1u); break; } }
    }
    nloc = mine > 0u ? mine : 1u; nx = cnt > 0u ? cnt : 1u;
}
__device__ __forceinline__ void xcd_barrier(const XcdBarrier& b) {
    asm volatile("s_waitcnt vmcnt(0)" ::: "memory");
    __syncthreads();
    if (threadIdx.x == 0) {
        unsigned* bar = b.bar;
        __builtin_amdgcn_s_waitcnt(0);
        unsigned nloc = b.st[0], nx = b.st[1];
        if (nloc == 0u) { xcd_barrier_complete(bar, b.x, nloc, nx); b.st[0] = nloc; b.st[1] = nx; }
        const unsigned old = xb_add(&bar[XB_XSUB(b.x)], 1u);
        const unsigned gen = old / nloc;
        if (old + 1u == (gen + 1u) * nloc) {
            __builtin_amdgcn_fence(__ATOMIC_RELEASE, "agent");
            asm volatile("s_waitcnt vmcnt(0)" ::: "memory");
            const unsigned og = xb_add(&bar[XB_TOP], 1u);
            const unsigned tg = og / nx;
            if (og + 1u == (tg + 1u) * nx) xb_add(&bar[XB_TOPGEN], 1u);
            else XB_SPIN(xb_ld(&bar[XB_TOPGEN]) == tg, bar);
            __builtin_amdgcn_fence(__ATOMIC_ACQUIRE, "agent");
            xb_add(&bar[XB_XGEN(b.x)], 1u);
            asm volatile("s_waitcnt vmcnt(0)" ::: "memory");
        } else {
            XB_SPIN(xb_ld(&bar[XB_XGEN(b.x)]) == gen, bar);
            __builtin_amdgcn_fence(__ATOMIC_ACQUIRE, "agent");
            asm volatile("s_waitcnt vmcnt(0)" ::: "memory");
        }
    }
    __syncthreads();
}

constexpr int RED_OFF = 131072, MISC_OFF = RED_OFF + 8192;
template <int NKS  , int CH>
__device__ __forceinline__ void skinny_resid(LAS unsigned char* lds, const bf16_t* A, const bf16_t* Bt, int item, const EpiResid& E) {
    constexpr int K = NKS * 128;
    int tid_ = threadIdx.x; asm volatile("" : "+v"(tid_));
    const int tid = tid_, lane = tid & 63, w = __builtin_amdgcn_readfirstlane(tid >> 6), fr = lane & 15, fq = lane >> 4;
    const int cgn = item >> 2, rh = item & 3, rsub = w & 1, ksp = w >> 1;
    const int rloc = 32 * rh + 16 * rsub + fr;
    const bf16_t* ap = A + (size_t)(MPR + rloc) * K + ksp * (NKS * 32) + 8 * fq;
    const bf16_t* bp = Bt + (size_t)(16 * cgn + fr) * K + ksp * (NKS * 32) + 8 * fq;
    f32x4 acc = (f32x4){0.f, 0.f, 0.f, 0.f};
#pragma unroll 1
    for (int c = 0; c < NKS / CH; ++c) {
        bf16x8 av[CH], bv[CH];
#pragma unroll
        for (int j = 0; j < CH; ++j) { av[j] = *(const bf16x8*)(ap + 32 * (c * CH + j)); bv[j] = *(const bf16x8*)(bp + 32 * (c * CH + j)); }
#pragma unroll
        for (int j = 0; j < CH; ++j) acc = __builtin_amdgcn_mfma_f32_16x16x32_bf16(bv[j], av[j], acc, 0, 0, 0);
    }
    LAS f32x4* red = (LAS f32x4*)(lds + RED_OFF);
    red[w * 64 + lane] = acc;
    __syncthreads();
    if (ksp == 0) {
        acc = acc + red[(w + 2) * 64 + lane] + red[(w + 4) * 64 + lane] + red[(w + 6) * 64 + lane];
        const int r = MPR + rloc, c = 16 * cgn + 4 * fq;
        f32x4 bs;
        if (E.xS) bs = *(const f32x4*)(E.xS + (size_t)rloc * D + c);
        else { const u32x2 hw = *(const u32x2*)(E.HB + (size_t)r * D + c); bs = (f32x4){bf_lo(hw.x), bf_hi(hw.x), bf_lo(hw.y), bf_hi(hw.y)}; }
        const f32x4 o = bs + acc * E.scale;
        float ss = (o[0] * o[0] + o[1] * o[1]) + (o[2] * o[2] + o[3] * o[3]);
        u32x2 wv; wv.x = cvt_pk_bf16(o[0], o[1]); wv.y = cvt_pk_bf16(o[2], o[3]);
        *(u32x2*)(E.HB + (size_t)r * D + c) = wv;
        ss += __shfl_xor(ss, 16); ss += __shfl_xor(ss, 32);
        if (fq == 0) atomicAdd(E.rowss_next + r, ss);
    }
    __syncthreads();
}

__device__ __forceinline__ void skinny_mixin(const bf16_t* A, const bf16_t* Bt, int item, const EpiMixIn& E) {
    int tid_ = threadIdx.x; asm volatile("" : "+v"(tid_));
    const int tid = tid_, lane = tid & 63, w = __builtin_amdgcn_readfirstlane(tid >> 6), fr = lane & 15, fq = lane >> 4;
    const int type = item >> 6, ch0 = (item & 63) * 16;
    const int brow0 = (type < 3) ? (type * 8 + (ch0 >> 7)) * 256 + (ch0 & 127) : 24 * 256 + ch0;
    const bf16_t* ap = A + (size_t)(MPR + 16 * w + fr) * D + 8 * fq;
    const bf16_t* bp0 = Bt + (size_t)(brow0 + fr) * D + 8 * fq;
    const bf16_t* bp1 = bp0 + (size_t)128 * D;
    f32x4 acc0 = (f32x4){0.f, 0.f, 0.f, 0.f}, acc1 = acc0;
    if (type < 3) {
#pragma unroll 1
        for (int c = 0; c < 4; ++c) {
            bf16x8 av[8], bv0[8], bv1[8];
#pragma unroll
            for (int j = 0; j < 8; ++j) { av[j] = *(const bf16x8*)(ap + 32 * (c * 8 + j)); bv0[j] = *(const bf16x8*)(bp0 + 32 * (c * 8 + j)); bv1[j] = *(const bf16x8*)(bp1 + 32 * (c * 8 + j)); }
#pragma unroll
            for (int j = 0; j < 8; ++j) { acc0 = __builtin_amdgcn_mfma_f32_16x16x32_bf16(bv0[j], av[j], acc0, 0, 0, 0); acc1 = __builtin_amdgcn_mfma_f32_16x16x32_bf16(bv1[j], av[j], acc1, 0, 0, 0); }
        }
    } else {
#pragma unroll 1
        for (int c = 0; c < 4; ++c) {
            bf16x8 av[8], bv0[8];
#pragma unroll
            for (int j = 0; j < 8; ++j) { av[j] = *(const bf16x8*)(ap + 32 * (c * 8 + j)); bv0[j] = *(const bf16x8*)(bp0 + 32 * (c * 8 + j)); }
#pragma unroll
            for (int j = 0; j < 8; ++j) acc0 = __builtin_amdgcn_mfma_f32_16x16x32_bf16(bv0[j], av[j], acc0, 0, 0, 0);
        }
    }
    const int sidx = 16 * w + fr, r = MPR + sidx, ch = ch0 + 4 * fq;
    const float rs = __builtin_amdgcn_rsqf(E.rowss[r] * (1.0f / D) + EPS);
    bf16_t* const GV = E.UG + (size_t)MPAD * D; bf16_t* const XG = GV + (size_t)MPAD * D; bf16_t* const BS = XG + (size_t)MPAD * D;
    if (type < 3) {
        const int o0 = type == 0 ? 0 : (type == 1 ? 3072 : 2048), o1 = type == 0 ? 5120 : (type == 1 ? 4096 : 6144);
        f32x4 p = acc0 * rs + *(const f32x4*)(E.bin + o0 + ch), q = acc1 * rs + *(const f32x4*)(E.bin + o1 + ch), res;
        if (type == 0) { p = gelu4(p);
#pragma unroll
            for (int j = 0; j < 4; ++j) res[j] = p[j] * sigmoidf_(q[j]); }
        else if (type == 1) { res = p * q; float* ncs = E.ncp + (O_NCS - O_NCP) + (size_t)E.l * (NS - NB) * 2 * D; *(f32x4*)(ncs + ((size_t)(sidx * 2 + 1)) * D + ch) = res; }
        else {
#pragma unroll
            for (int j = 0; j < 4; ++j) res[j] = p[j] * sigmoidf_(q[j]); }
        bf16_t* O = type == 0 ? E.UG : (type == 1 ? XG : BS);
        u32x2 wv; wv.x = cvt_pk_bf16(res[0], res[1]); wv.y = cvt_pk_bf16(res[2], res[3]);
        *(u32x2*)(O + (size_t)r * D + ch) = wv;
    } else {
        const f32x4 v = gelu4(acc0 * rs + *(const f32x4*)(E.bin + 1024 + ch));
        float s1 = (v[0] + v[1]) + (v[2] + v[3]), s2 = (v[0] * v[0] + v[1] * v[1]) + (v[2] * v[2] + v[3] * v[3]);
        u32x2 wv; wv.x = cvt_pk_bf16(v[0], v[1]); wv.y = cvt_pk_bf16(v[2], v[3]);
        *(u32x2*)(GV + (size_t)r * D + ch) = wv;
        s1 += __shfl_xor(s1, 16); s1 += __shfl_xor(s1, 32); s2 += __shfl_xor(s2, 16); s2 += __shfl_xor(s2, 32);
        if (fq == 0) { atomicAdd(E.vsum + r, s1); atomicAdd(E.vsum + MPAD + r, s2); }
    }
}

struct Args { const float* in[21]; float* out; unsigned char* ws; };
typedef const __attribute__((address_space(4))) Args* KArgs;
__device__ __forceinline__ KArgs kargs() { KArgs p = (KArgs)__builtin_amdgcn_kernarg_segment_ptr(); asm volatile("" : "+s"(p)); return p; }
enum { I_XP = 0, I_XS, I_STATE, I_F1N, I_F1G, I_F1U, I_F1D, I_MIXN, I_WIN, I_BIN, I_VG, I_VB, I_WSP, I_BSP, I_CW, I_WO, I_F2N, I_F2G, I_F2U, I_F2D, I_FN };

__device__ __forceinline__ void transpose_item(const float* W, int N, int srccol0, const float* gain, bf16_t* WT, int K, int destrow0, int k0, int lane) {
    const int nq = lane & 15, ko = lane >> 4;
#pragma unroll
    for (int h = 0; h < 2; ++h) {
        const int kb = k0 + 32 * h + 8 * ko;
        f32x4 v[8];
#pragma unroll
        for (int j = 0; j < 8; ++j) v[j] = *(const f32x4*)(W + (size_t)(kb + j) * N + srccol0 + 4 * nq);
        if (gain) { const f32x4 g0 = *(const f32x4*)(gain + kb), g1 = *(const f32x4*)(gain + kb + 4);
#pragma unroll
            for (int j = 0; j < 4; ++j) { v[j] = v[j] * g0[j]; v[4 + j] = v[4 + j] * g1[j]; } }
#pragma unroll
        for (int i = 0; i < 4; ++i) { u32x4 o; o.x = cvt_pk_bf16(v[0][i], v[1][i]); o.y = cvt_pk_bf16(v[2][i], v[3][i]); o.z = cvt_pk_bf16(v[4][i], v[5][i]); o.w = cvt_pk_bf16(v[6][i], v[7][i]);
            *(u32x4*)(WT + (size_t)(destrow0 + 4 * nq + i) * K + kb) = o; }
    }
}
__device__ __forceinline__ int win_srccol(int nprime) {
    const int pn = nprime >> 8, w = nprime & 255, half = w >> 7, cw = w & 127;
    if (pn < 8) return (half ? 5120 : 0) + 128 * pn + cw;
    if (pn < 16) return (half ? 4096 : 3072) + 128 * (pn - 8) + cw;
    if (pn < 24) return (half ? 6144 : 2048) + 128 * (pn - 16) + cw;
    return 1024 + 256 * (pn - 24) + w;
}
constexpr int IT_W1 = 16 * 88, IT_W2 = 44 * 16, IT_WIN = 16 * 112, IT_WO = 16 * 16, IT_LAYER = 2 * IT_W1 + 2 * IT_W2 + IT_WIN + IT_WO;


__device__ __forceinline__ void convert_item(KArgs a, int l, int mat, int r, int lane) {
    bf16_t* WL = (bf16_t*)(a->ws + WS_W) + (size_t)l * LAYER_W_ELEMS;
    if (mat == 0 || mat == 4) { const int which = mat == 4; const int kb = r / 88, nb = r % 88, np = 64 * nb, pn = np >> 8, w = np & 255, half = w >> 7, cw = w & 127;
        const float* src = a->in[which ? (half ? I_F2U : I_F2G) : (half ? I_F1U : I_F1G)] + (size_t)l * D * FF;
        transpose_item(src, FF, 128 * pn + cw, a->in[which ? I_F2N : I_F1N] + l * D, WL + (which ? OW6 : OW1), D, np, 64 * kb, lane); }
    else if (mat == 1 || mat == 5) { const int which = mat == 5; const int kb = r / 16, nb = r % 16;
        transpose_item(a->in[which ? I_F2D : I_F1D] + (size_t)l * FF * D, D, 64 * nb, nullptr, WL + (which ? OW7 : OW2), FF, 64 * nb, 64 * kb, lane); }
    else if (mat == 2) { const int kb = r / 112, nb = r % 112;
        transpose_item(a->in[I_WIN] + (size_t)l * D * NIN, NIN, win_srccol(64 * nb), a->in[I_MIXN] + l * D, WL + OWIN, D, 64 * nb, 64 * kb, lane); }
    else { const int kb = r / 16, nb = r % 16;
        transpose_item(a->in[I_WO] + (size_t)l * D * D, D, 64 * nb, nullptr, WL + OWO, D, 64 * nb, 64 * kb, lane); }
}
__device__ __forceinline__ void convert_group(KArgs a, int grp, int slot, int nslots, int lane) {
    int sl[4] = {0, 0, 0, 0}, sm[4] = {0, 0, 0, 0}, sn[4] = {0, 0, 0, 0};
    if (grp == 0)      { sl[0] = 0; sm[0] = 0; sn[0] = IT_W1;  sl[1] = 0; sm[1] = 4; sn[1] = IT_W1; }
    else if (grp == 1) { sl[0] = 0; sm[0] = 1; sn[0] = IT_W2;  sl[1] = 0; sm[1] = 2; sn[1] = IT_WIN; sl[2] = 0; sm[2] = 3; sn[2] = IT_WO; }
    else if (grp == 2) { sl[0] = 0; sm[0] = 5; sn[0] = IT_W2;  sl[1] = 1; sm[1] = 0; sn[1] = IT_W1;  sl[2] = 1; sm[2] = 1; sn[2] = IT_W2;  sl[3] = 1; sm[3] = 4; sn[3] = IT_W1; }
    else if (grp == 3) { sl[0] = 1; sm[0] = 2; sn[0] = IT_WIN; sl[1] = 1; sm[1] = 3; sn[1] = IT_WO; }
    else               { sl[0] = 1; sm[0] = 5; sn[0] = IT_W2; }
    const int total = sn[0] + sn[1] + sn[2] + sn[3];
    for (int q = slot; q < total; q += nslots) {
        int r = q, l = sl[0], m = sm[0];
        if (r >= sn[0]) { r -= sn[0]; l = sl[1]; m = sm[1];
            if (r >= sn[1]) { r -= sn[1]; l = sl[2]; m = sm[2];
                if (r >= sn[2]) { r -= sn[2]; l = sl[3]; m = sm[3]; } } }
        convert_item(a, l, m, r, lane);
    }
}
constexpr int N_GU_UNITS = (MPAD / 256) * (2 * FF / 256);
__device__ __forceinline__ void convert_in_tail(KArgs a, int grp, int G, int bid) {
    int tid_ = threadIdx.x; asm volatile("" : "+v"(tid_));
    const int lane = tid_ & 63, wave = tid_ >> 6, rem = N_GU_UNITS % G;
    if (rem == 0) convert_group(a, grp, bid * 8 + wave, G * 8, lane);
    else if (bid >= rem) convert_group(a, grp, (bid - rem) * 8 + wave, (G - rem) * 8, lane);
}

__device__ __forceinline__ void prologue(KArgs a, LAS unsigned char* lds) {
    const int tid = threadIdx.x, lane = tid & 63, wave = tid >> 6;
    const int gw = blockIdx.x * 8 + wave, NGW = gridDim.x * 8;
    float* stat = (float*)(a->ws + WS_STAT);
    for (size_t i = (size_t)blockIdx.x * 512 + tid; i < (size_t)10 * MPAD; i += (size_t)gridDim.x * 512) stat[MPAD + i] = 0.f;
    if (blockIdx.x == 0 && tid < MPAD - M) stat[M + tid] = 0.f;
    bf16_t* HB = (bf16_t*)(a->ws + WS_HB);
    for (int r = gw; r < M; r += 2 * NGW) {
        const int r2 = r + NGW; const bool has2 = r2 < M;
        const float* xr = (r < MPR) ? a->in[I_XP] + (size_t)r * D : a->in[I_XS] + (size_t)(r - MPR) * D;
        const float* xr2 = has2 ? ((r2 < MPR) ? a->in[I_XP] + (size_t)r2 * D : a->in[I_XS] + (size_t)(r2 - MPR) * D) : xr;
        const f32x4* x4 = (const f32x4*)xr + lane; const f32x4* y4 = (const f32x4*)xr2 + lane;
        f32x4 va[4], vb[4];
#pragma unroll
        for (int j = 0; j < 4; ++j) { va[j] = x4[64 * j]; vb[j] = y4[64 * j]; }
        unsigned long long* o8 = (unsigned long long*)(HB + (size_t)r * D) + lane;
        float s = 0.f, s2 = 0.f;
#pragma unroll
        for (int j = 0; j < 4; ++j) { const f32x4 v = va[j]; s += (v[0] * v[0] + v[1] * v[1]) + (v[2] * v[2] + v[3] * v[3]);
            o8[64 * j] = (unsigned long long)cvt_pk_bf16(v[0], v[1]) | ((unsigned long long)cvt_pk_bf16(v[2], v[3]) << 32); }
        s = wave_sum(s);
        if (lane == 0) stat[r] = s;
        if (has2) { unsigned long long* p8 = (unsigned long long*)(HB + (size_t)r2 * D) + lane;
#pragma unroll
            for (int j = 0; j < 4; ++j) { const f32x4 v = vb[j]; s2 += (v[0] * v[0] + v[1] * v[1]) + (v[2] * v[2] + v[3] * v[3]);
                p8[64 * j] = (unsigned long long)cvt_pk_bf16(v[0], v[1]) | ((unsigned long long)cvt_pk_bf16(v[2], v[3]) << 32); }
            s2 = wave_sum(s2);
            if (lane == 0) stat[r2] = s2; }
    }
    for (int i = blockIdx.x * 512 + tid; i < DEPTH * NS * (D / 4); i += gridDim.x * 512) {
        const int ls = i / (D / 4), c4 = i % (D / 4);
        *((f32x4*)(a->out + O_NCS + (size_t)(ls * 2) * D) + c4) = *((const f32x4*)(a->in[I_STATE] + (size_t)(ls * 2 + 1) * D) + c4);
    }
    convert_group(a, 0, gw, NGW, lane);
}

constexpr int T_OFF = 0, W_OFF = 65536, WROW = 272, Z_OFF = 0, ZROW = 1040, ST_OFF = 133120, BSP_OFF = ST_OFF + 1024;
__device__ __forceinline__ int tsw(int d) { const int v = d & 15; return (v ^ ((v >> 3) << 2)) ^ ((d >> 4) & 15); }
__device__ __forceinline__ void mix_prompt_item(KArgs a, LAS unsigned char* lds, int l, int chunk, int g) {
    int tid_ = threadIdx.x; asm volatile("" : "+v"(tid_));
    const int tid = tid_, lane = tid & 63, wave = __builtin_amdgcn_readfirstlane(tid >> 6), fr = lane & 15, fq = lane >> 4;
    float* stat = (float*)(a->ws + WS_STAT);
    const float* vsum = stat + (size_t)(7 + 2 * l) * MPAD; const float* vsq = vsum + MPAD;
    bf16_t* UG = (bf16_t*)(a->ws + WS_R); const bf16_t* GV = UG + (size_t)MPAD * D; const bf16_t* XG = GV + (size_t)MPAD * D; const bf16_t* BS = XG + (size_t)MPAD * D;
    const int row0 = chunk * 128;
    LAS float* st = (LAS float*)(lds + ST_OFF);
    LAS float* bspL = (LAS float*)(lds + BSP_OFF);
    if (tid < 128) { const int r = row0 + tid; const float mean = vsum[r] * (1.0f / D); const float var = fmaxf(vsq[r] * (1.0f / D) - mean * mean, 0.f);
        st[2 * tid] = mean; st[2 * tid + 1] = __builtin_amdgcn_rsqf(var + EPS); }
    else if (tid < 256) bspL[tid - 128] = a->in[I_BSP][(l * 4 + g) * 128 + (tid - 128)];
    {
        const int t = tid >> 2, s0 = (tid & 3) * 32; const float* wp = a->in[I_WSP] + ((size_t)(l * 4 + g) * 128 + t) * 128 + s0;
#pragma unroll
        for (int q = 0; q < 4; ++q) { const f32x4 w0 = *(const f32x4*)(wp + 8 * q), w1 = *(const f32x4*)(wp + 8 * q + 4); float e[8] = {w0[0], w0[1], w0[2], w0[3], w1[0], w1[1], w1[2], w1[3]};
#pragma unroll
            for (int j = 0; j < 8; ++j) e[j] = (s0 + 8 * q + j <= t) ? e[j] : 0.f;
            u32x4 o; o.x = cvt_pk_bf16(e[0], e[1]); o.y = cvt_pk_bf16(e[2], e[3]); o.z = cvt_pk_bf16(e[4], e[5]); o.w = cvt_pk_bf16(e[6], e[7]);
            *(LAS u32x4*)(lds + W_OFF + t * WROW + (s0 + 8 * q) * 2) = o; }
    }
    __syncthreads();
    {
        const int dq = lane & 7, sp = lane >> 3;
        const float* vg = a->in[I_VG] + l * D + 256 * g; const float* vb = a->in[I_VB] + l * D + 256 * g;
#pragma unroll
        for (int i = 0; i < 4; ++i) { const int q = wave * 4 + i, db = q & 3, rb = q >> 2, d0 = 64 * db + 8 * dq, s0 = 16 * rb + 2 * sp;
            const u32x4 xa = *(const u32x4*)(GV + (size_t)(row0 + s0) * D + 256 * g + d0), xb = *(const u32x4*)(GV + (size_t)(row0 + s0 + 1) * D + 256 * g + d0);
            const f32x4 g0 = *(const f32x4*)(vg + d0), g1 = *(const f32x4*)(vg + d0 + 4), c0 = *(const f32x4*)(vb + d0), c1 = *(const f32x4*)(vb + d0 + 4);
            const float ma = st[2 * s0], ra = st[2 * s0 + 1], mb = st[2 * s0 + 2], rb_ = st[2 * s0 + 3];
            const float ea[8] = {bf_lo(xa.x), bf_hi(xa.x), bf_lo(xa.y), bf_hi(xa.y), bf_lo(xa.z), bf_hi(xa.z), bf_lo(xa.w), bf_hi(xa.w)};
            const float eb[8] = {bf_lo(xb.x), bf_hi(xb.x), bf_lo(xb.y), bf_hi(xb.y), bf_lo(xb.z), bf_hi(xb.z), bf_lo(xb.w), bf_hi(xb.w)};
            const float gg[8] = {g0[0], g0[1], g0[2], g0[3], g1[0], g1[1], g1[2], g1[3]}; const float cc[8] = {c0[0], c0[1], c0[2], c0[3], c1[0], c1[1], c1[2], c1[3]};
            const int spi = 8 * rb + sp, c = spi >> 2, wi = spi & 3;
#pragma unroll
            for (int j = 0; j < 8; ++j) { const int d = d0 + j; const float va = (ea[j] - ma) * ra * gg[j] + cc[j], vb2 = (eb[j] - mb) * rb_ * gg[j] + cc[j];
                *(LAS unsigned*)(lds + T_OFF + d * 256 + ((c ^ tsw(d)) << 4) + wi * 4) = cvt_pk_bf16(va, vb2); }
        }
    }
    __syncthreads();
    f32x4 acc[16];
#pragma unroll
    for (int n = 0; n < 16; ++n) acc[n] = (f32x4){0.f, 0.f, 0.f, 0.f};
    const int kmax = (16 * wave + 15) >> 5;
    for (int ks = 0; ks <= kmax; ++ks) {
        const bf16x8 af = *(const LAS bf16x8*)(lds + W_OFF + (16 * wave + fr) * WROW + (32 * ks + 8 * fq) * 2);
#pragma unroll
        for (int n = 0; n < 16; ++n) { const int d = 16 * n + fr; const bf16x8 bfr = *(const LAS bf16x8*)(lds + T_OFF + d * 256 + (((4 * ks + fq) ^ tsw(d)) << 4));
            acc[n] = __builtin_amdgcn_mfma_f32_16x16x32_bf16(bfr, af, acc[n], 0, 0, 0); }
    }
    __syncthreads();
#pragma unroll
    for (int n = 0; n < 16; ++n) *(LAS f32x4*)(lds + Z_OFF + (16 * wave + fr) * ZROW + (16 * n + 4 * fq) * 4) = acc[n];
    __syncthreads();
    {
        const int o8 = (lane & 31) * 8, dcol = 256 * g + o8;
        const float* cw = a->in[I_CW] + (size_t)l * 3 * D + dcol;
        const f32x4 w0a = *(const f32x4*)(cw), w0b = *(const f32x4*)(cw + 4), w1a = *(const f32x4*)(cw + D), w1b = *(const f32x4*)(cw + D + 4), w2a = *(const f32x4*)(cw + 2 * D), w2b = *(const f32x4*)(cw + 2 * D + 4);
        const float w0[8] = {w0a[0], w0a[1], w0a[2], w0a[3], w0b[0], w0b[1], w0b[2], w0b[3]}, w1[8] = {w1a[0], w1a[1], w1a[2], w1a[3], w1b[0], w1b[1], w1b[2], w1b[3]}, w2[8] = {w2a[0], w2a[1], w2a[2], w2a[3], w2b[0], w2b[1], w2b[2], w2b[3]};
#pragma unroll 4
        for (int i = 0; i < 8; ++i) { const int t = 16 * wave + 2 * i + (lane >> 5), r = row0 + t, tseq = r & (SEQ - 1); const size_t off = (size_t)r * D + dcol;
            const u32x4 ug = *(const u32x4*)(UG + off), bs = *(const u32x4*)(BS + off), x0 = *(const u32x4*)(XG + off);
            u32x4 x1 = (u32x4){0u, 0u, 0u, 0u}, x2 = (u32x4){0u, 0u, 0u, 0u};
            if (tseq >= 1) x1 = *(const u32x4*)(XG + off - D);
            if (tseq >= 2) x2 = *(const u32x4*)(XG + off - 2 * D);
            const f32x4 za = *(const LAS f32x4*)(lds + Z_OFF + t * ZROW + o8 * 4), zb = *(const LAS f32x4*)(lds + Z_OFF + t * ZROW + o8 * 4 + 16);
            const float bsp = bspL[t];
            const float z[8] = {za[0], za[1], za[2], za[3], zb[0], zb[1], zb[2], zb[3]};
            const unsigned ugw[4] = {ug.x, ug.y, ug.z, ug.w}, bsw[4] = {bs.x, bs.y, bs.z, bs.w}, x0w[4] = {x0.x, x0.y, x0.z, x0.w}, x1w[4] = {x1.x, x1.y, x1.z, x1.w}, x2w[4] = {x2.x, x2.y, x2.z, x2.w};
            unsigned ow[4];
#pragma unroll
            for (int p = 0; p < 4; ++p) {
                const float m0 = bf_lo(ugw[p]) * (z[2 * p] + bsp) + bf_lo(bsw[p]) * (w0[2 * p] * bf_lo(x2w[p]) + w1[2 * p] * bf_lo(x1w[p]) + w2[2 * p] * bf_lo(x0w[p]));
                const float m1 = bf_hi(ugw[p]) * (z[2 * p + 1] + bsp) + bf_hi(bsw[p]) * (w0[2 * p + 1] * bf_hi(x2w[p]) + w1[2 * p + 1] * bf_hi(x1w[p]) + w2[2 * p + 1] * bf_hi(x0w[p]));
                ow[p] = cvt_pk_bf16(m0, m1); }
            *(u32x4*)(UG + off) = (u32x4){ow[0], ow[1], ow[2], ow[3]}; }
    }
    __syncthreads();
}
__device__ __forceinline__ void mix_sample_item(KArgs a, int l, int item) {
    int tid_ = threadIdx.x; asm volatile("" : "+v"(tid_));
    const int tid = tid_, s = 4 * item + (tid >> 7), d = (tid & 127) * 8, g = d >> 8, r = MPR + s;
    float* stat = (float*)(a->ws + WS_STAT);
    const float* vsum = stat + (size_t)(7 + 2 * l) * MPAD; const float* vsq = vsum + MPAD;
    bf16_t* UG = (bf16_t*)(a->ws + WS_R); const bf16_t* GV = UG + (size_t)MPAD * D; const bf16_t* XG = GV + (size_t)MPAD * D; const bf16_t* BS = XG + (size_t)MPAD * D;
    const float w00 = a->in[I_WSP][(size_t)(l * 4 + g) * 128 * 128], b0 = a->in[I_BSP][(l * 4 + g) * 128];
    const float* cw = a->in[I_CW] + (size_t)l * 3 * D + d;
    const size_t off = (size_t)r * D + d;
    const float mean = vsum[r] * (1.0f / D); const float var = fmaxf(vsq[r] * (1.0f / D) - mean * mean, 0.f); const float rstd = __builtin_amdgcn_rsqf(var + EPS);
    const u32x4 gv = *(const u32x4*)(GV + off), ug = *(const u32x4*)(UG + off), bs = *(const u32x4*)(BS + off), xg = *(const u32x4*)(XG + off);
    const float* st0 = a->in[I_STATE] + ((size_t)(l * NS + s) * 2) * D + d; const float* vgp = a->in[I_VG] + l * D + d; const float* vbp = a->in[I_VB] + l * D + d;
    float* vo = a->out + O_VS + ((size_t)(l * NS + s)) * D + d;
    const unsigned gvw[4] = {gv.x, gv.y, gv.z, gv.w}, ugw[4] = {ug.x, ug.y, ug.z, ug.w}, bsw[4] = {bs.x, bs.y, bs.z, bs.w}, xgw[4] = {xg.x, xg.y, xg.z, xg.w};
    unsigned ow[4];
#pragma unroll
    for (int h = 0; h < 2; ++h) {
        const f32x4 sa = *(const f32x4*)(st0 + 4 * h), sb = *(const f32x4*)(st0 + D + 4 * h), gn = *(const f32x4*)(vgp + 4 * h), bi = *(const f32x4*)(vbp + 4 * h);
        const f32x4 c0 = *(const f32x4*)(cw + 4 * h), c1 = *(const f32x4*)(cw + D + 4 * h), c2 = *(const f32x4*)(cw + 2 * D + 4 * h);
        f32x4 vp;
#pragma unroll
        for (int p = 0; p < 2; ++p) { const int wq = 2 * h + p, j0 = 2 * p;
            const float v0 = (bf_lo(gvw[wq]) - mean) * rstd * gn[j0] + bi[j0], v1 = (bf_hi(gvw[wq]) - mean) * rstd * gn[j0 + 1] + bi[j0 + 1];
            vp[j0] = v0; vp[j0 + 1] = v1;
            const float cv0 = c0[j0] * sa[j0] + c1[j0] * sb[j0] + c2[j0] * bf_lo(xgw[wq]), cv1 = c0[j0 + 1] * sa[j0 + 1] + c1[j0 + 1] * sb[j0 + 1] + c2[j0 + 1] * bf_hi(xgw[wq]);
            ow[wq] = cvt_pk_bf16(bf_lo(ugw[wq]) * (w00 * v0 + b0) + bf_lo(bsw[wq]) * cv0, bf_hi(ugw[wq]) * (w00 * v1 + b0) + bf_hi(bsw[wq]) * cv1); }
        *(f32x4*)(vo + 4 * h) = vp;
    }
    *(u32x4*)(UG + off) = (u32x4){ow[0], ow[1], ow[2], ow[3]};
}

#ifndef PROBE_MASK
#define PROBE_MASK 0
#endif
#ifndef PROBE_AMP
#define PROBE_AMP 4
#endif
#if PROBE_MASK
#define STAMP(i) do { if (blockIdx.x == 0 && threadIdx.x == 0) { volatile LAS unsigned long long* pw_ = (volatile LAS unsigned long long*)(lds + MISC_OFF + 16); \
    const unsigned long long t_ = __builtin_amdgcn_s_memrealtime(); if ((((unsigned)PROBE_MASK) >> (i)) & 1u) pw_[1] += t_ - pw_[0]; pw_[0] = t_; } } while (0)
#else
#define STAMP(i) do { } while (0)
#endif
__global__ void __launch_bounds__(512, 2) fwd_megakernel(Args a_unused) {
    extern __shared__ __attribute__((aligned(16))) unsigned char lds_raw[];
    LAS unsigned char* lds = (LAS unsigned char*)lds_raw;
    cg::grid_group grid = cg::this_grid();
    const int G = gridDim.x, bid = blockIdx.x;

    if (threadIdx.x < 8) ((LAS unsigned*)(lds + MISC_OFF))[threadIdx.x] = 0u;
    __syncthreads();
    { KArgs p = kargs(); if (p->ws == nullptr) grid.sync();
      (void)xcd_barrier_post((unsigned*)(p->ws + WS_BAR), (volatile LAS unsigned*)(lds + MISC_OFF)); }
#define GRID_SYNC() do { XcdBarrier b_; b_.bar = (unsigned*)(kargs()->ws + WS_BAR); b_.x = xb_xcc_id(); b_.st = (volatile LAS unsigned*)(lds + MISC_OFF); xcd_barrier(b_); } while (0)
#if PROBE_MASK
    if (blockIdx.x == 0 && threadIdx.x == 0) { volatile LAS unsigned long long* pw_ = (volatile LAS unsigned long long*)(lds + MISC_OFF + 16); pw_[0] = __builtin_amdgcn_s_memrealtime(); pw_[1] = 0ull; }
#endif
    prologue(kargs(), lds);
    GRID_SYNC(); STAMP(0);
#pragma unroll 1
    for (int l = 0; l < DEPTH; ++l) {
        {
            KArgs p = kargs(); unsigned char* ws = p->ws;
            pg8::Gemm g{(const bf16_t*)(ws + WS_HB), (const bf16_t*)(ws + WS_W) + (size_t)l * LAYER_W_ELEMS + OW1, MPAD, 2 * FF, D}; pg8::StaticOrder S; S.init(MPAD, 2 * FF, G, bid);
            EpiSwiglu E{(bf16_t*)(ws + WS_R), (const float*)(ws + WS_STAT) + (size_t)(3 * l) * MPAD};
            pg8::gemm_phase<EpiSwiglu, true>(lds, g, S, E);
            convert_in_tail(kargs(), l == 0 ? 1 : 3, G, bid);
        }
        GRID_SYNC(); STAMP(1 + 7 * l + 0);
        {
            KArgs p = kargs(); unsigned char* ws = p->ws;
            pg8::Gemm g{(const bf16_t*)(ws + WS_R), (const bf16_t*)(ws + WS_W) + (size_t)l * LAYER_W_ELEMS + OW2, MPAD, D, FF}; pg8::StaticOrder S; S.init(MPR, D, G, bid);
            EpiResid E{l == 0 ? p->in[I_XP] : nullptr, l == 0 ? p->in[I_XS] : nullptr, (bf16_t*)(ws + WS_HB), (float*)(ws + WS_STAT) + (size_t)(3 * l + 1) * MPAD, 0.5f};
            if (!(bid & 1)) for (int it = bid; it < 256; it += G) skinny_resid<22, 11>(lds, g.A, g.Bt, it, E);
            pg8::gemm_phase<EpiResid, true>(lds, g, S, E);
            if (bid & 1) for (int it = bid; it < 256; it += G) skinny_resid<22, 11>(lds, g.A, g.Bt, it, E);
        }
        GRID_SYNC(); STAMP(1 + 7 * l + 1);
        {
            KArgs p = kargs(); unsigned char* ws = p->ws;
            pg8::Gemm g{(const bf16_t*)(ws + WS_HB), (const bf16_t*)(ws + WS_W) + (size_t)l * LAYER_W_ELEMS + OWIN, MPAD, NIN, D}; pg8::StaticOrder S; S.init(MPR, NIN, G, bid);
            EpiMixIn E{(bf16_t*)(ws + WS_R), (const float*)(ws + WS_STAT) + (size_t)(3 * l + 1) * MPAD, p->in[I_BIN] + (size_t)l * NIN, (float*)(ws + WS_STAT) + (size_t)(7 + 2 * l) * MPAD,
                       p->out + O_NCP + (size_t)l * NB * 2 * D, l};
            for (int it = bid; it < 256; it += G) skinny_mixin(g.A, g.Bt, it, E);
            pg8::gemm_phase<EpiMixIn, true>(lds, g, S, E);
        }
        GRID_SYNC(); STAMP(1 + 7 * l + 2);
        {
            KArgs p = kargs();
            for (int it = bid; it < 544; it += G) {
                if (it < 512) mix_prompt_item(p, lds, l, it >> 2, it & 3); else mix_sample_item(p, l, it - 512);
            }
        }
        GRID_SYNC(); STAMP(1 + 7 * l + 3);
        {
            KArgs p = kargs(); unsigned char* ws = p->ws;
            pg8::Gemm g{(const bf16_t*)(ws + WS_R), (const bf16_t*)(ws + WS_W) + (size_t)l * LAYER_W_ELEMS + OWO, MPAD, D, D}; pg8::StaticOrder S; S.init(MPR, D, G, bid);
            EpiResid E{nullptr, nullptr, (bf16_t*)(ws + WS_HB), (float*)(ws + WS_STAT) + (size_t)(3 * l + 2) * MPAD, 1.0f};
            if (!(bid & 1)) for (int it = bid; it < 256; it += G) skinny_resid<8, 8>(lds, g.A, g.Bt, it, E);
            pg8::gemm_phase<EpiResid, true>(lds, g, S, E);
            if (bid & 1) for (int it = bid; it < 256; it += G) skinny_resid<8, 8>(lds, g.A, g.Bt, it, E);
        }
        GRID_SYNC(); STAMP(1 + 7 * l + 4);
        {
            KArgs p = kargs(); unsigned char* ws = p->ws;
            pg8::Gemm g{(const bf16_t*)(ws + WS_HB), (const bf16_t*)(ws + WS_W) + (size_t)l * LAYER_W_ELEMS + OW6, MPAD, 2 * FF, D}; pg8::StaticOrder S; S.init(MPAD, 2 * FF, G, bid);
            EpiSwiglu E{(bf16_t*)(ws + WS_R), (const float*)(ws + WS_STAT) + (size_t)(3 * l + 2) * MPAD};
            pg8::gemm_phase<EpiSwiglu, true>(lds, g, S, E);
            convert_in_tail(kargs(), l == 0 ? 2 : 4, G, bid);
        }
        GRID_SYNC(); STAMP(1 + 7 * l + 5);
        {
            KArgs p = kargs(); unsigned char* ws = p->ws;
            pg8::Gemm g{(const bf16_t*)(ws + WS_R), (const bf16_t*)(ws + WS_W) + (size_t)l * LAYER_W_ELEMS + OW7, MPAD, D, FF}; pg8::StaticOrder S; S.init(MPR, D, G, bid);
            EpiResid E{nullptr, nullptr, (bf16_t*)(ws + WS_HB), (float*)(ws + WS_STAT) + (size_t)(3 * l + 3) * MPAD, 0.5f};
            if (!(bid & 1)) for (int it = bid; it < 256; it += G) skinny_resid<22, 11>(lds, g.A, g.Bt, it, E);
            pg8::gemm_phase<EpiResid, true>(lds, g, S, E);
            if (bid & 1) for (int it = bid; it < 256; it += G) skinny_resid<22, 11>(lds, g.A, g.Bt, it, E);
        }
        GRID_SYNC(); STAMP(1 + 7 * l + 6);
    }
    {
        KArgs p = kargs();
        int tid_ = threadIdx.x; asm volatile("" : "+v"(tid_));
        const int tid = tid_, lane = tid & 63, wave = tid >> 6;
        const float* rsf = (const float*)(p->ws + WS_STAT) + (size_t)6 * MPAD;
        const f32x4* fn4 = (const f32x4*)p->in[I_FN] + lane;
        float* Y = p->out; const bf16_t* HBf = (const bf16_t*)(p->ws + WS_HB);
        for (int r = bid * 8 + wave; r < M; r += G * 8) {
            const float rs = __builtin_amdgcn_rsqf(rsf[r] * (1.0f / D) + EPS);
            f32x4* y = (f32x4*)(Y + (size_t)r * D) + lane;
            const u32x2* hrow = (const u32x2*)(HBf + (size_t)r * D) + lane;
#pragma unroll
            for (int j = 0; j < 4; ++j) { const u32x2 hw = hrow[64 * j]; y[64 * j] = (f32x4){bf_lo(hw.x), bf_hi(hw.x), bf_lo(hw.y), bf_hi(hw.y)} * rs * fn4[64 * j]; }
        }
    }
#if PROBE_MASK
    STAMP(15);
    if (blockIdx.x == 0 && threadIdx.x == 0) { volatile LAS unsigned long long* pw_ = (volatile LAS unsigned long long*)(lds + MISC_OFF + 16); const unsigned long long t0_ = pw_[0], tg_ = pw_[1] * PROBE_AMP;
        while (__builtin_amdgcn_s_memrealtime() - t0_ < tg_) __builtin_amdgcn_s_sleep(20); }
#endif
}

extern "C" void kernel_launch(void* const* d_in, const int* in_sizes, int n_in, void* d_out, int out_size, void* d_ws, size_t ws_size, hipStream_t stream) {
    static int grid = 0;
    if (grid == 0) {
        if (n_in != 21 || ws_size < WS_END) { fprintf(stderr, "kernel_launch: bad setup n_in %d ws %zu (need %zu)\n", n_in, ws_size, (size_t)WS_END); grid = -1; return; }
        int dev = 0, cus = 0, per_cu = 0;
        (void)hipGetDevice(&dev);
        (void)hipDeviceGetAttribute(&cus, hipDeviceAttributeMultiprocessorCount, dev);
        (void)hipFuncSetAttribute((const void*)fwd_megakernel, hipFuncAttributeMaxDynamicSharedMemorySize, LDS_BYTES);
        (void)hipOccupancyMaxActiveBlocksPerMultiprocessor(&per_cu, (const void*)fwd_megakernel, 512, LDS_BYTES);
        if (per_cu < 1) per_cu = 1;
        grid = cus * per_cu;
        (void)hipGetLastError();
    }
    if (grid < 0) return;
    if (hipMemsetAsync((char*)d_ws + WS_BAR, 0, BAR_BYTES, stream) != hipSuccess) { fprintf(stderr, "memset failed\n"); return; }
    Args a{};
    for (int i = 0; i < 21; ++i) a.in[i] = (const float*)d_in[i];
    a.out = (float*)d_out; a.ws = (unsigned char*)d_ws;
    void* args[] = {&a};
    hipError_t e = hipLaunchCooperativeKernel((const void*)fwd_megakernel, dim3(grid), dim3(512), args, LDS_BYTES, stream);
    if (e != hipSuccess) fprintf(stderr, "cooperative launch failed: %s (grid %d)\n", hipGetErrorString(e), grid);
}
```
